# Optimizing an MI355X kernel written in HIP

```python
import math
import jax
import jax.numpy as jnp
from jax import lax
import numpy as np

D_MODEL = 4096
BATCH = 1
SEQ = 8192
DEPTH = 1

D_MIX = D_MODEL
D_RWKV = D_MIX // 2
D_DIFF = D_MIX - D_RWKV
RWKV_HEAD = 64
N_RWKV_HEADS = D_RWKV // RWKV_HEAD
DECAY_RANK = 96
ICLR_RANK = 96
GATE_RANK = 256
DIFF_D = 64
DIFF_HEAD = 2 * DIFF_D
N_DIFF_HEADS = D_DIFF // DIFF_HEAD
D_FF = 256 * ((8 * D_MODEL // 3 + 255) // 256)
Q_BLOCK = 128
ALIBI_MAX_EXP = 8.0
NORM_EPS = 1e-6
RWKV_GN_EPS = 64e-5
SUBLN_EPS = 1e-5
FFN_RESIDUAL = 0.5

RWKV_SPLITS = (D_RWKV, 2 * D_RWKV, 3 * D_RWKV, 3 * D_RWKV + DECAY_RANK, 3 * D_RWKV + DECAY_RANK + ICLR_RANK)
RWKV_COLS = 3 * D_RWKV + DECAY_RANK + ICLR_RANK + GATE_RANK
DIFF_COLS = 3 * D_DIFF
D_IN = RWKV_COLS + DIFF_COLS

kernel_name = "hybrid_rwkv7_diffattn_macaron_block"


def rms_norm(x, g, eps=NORM_EPS):
    xf = x.astype(jnp.float32)
    y = xf * lax.rsqrt(jnp.mean(xf * xf, axis=-1, keepdims=True) + eps)
    return (y * g.astype(jnp.float32)).astype(x.dtype)


def swiglu(x, w_gate, w_up, w_down):
    return (jax.nn.silu(x @ w_gate) * (x @ w_up)) @ w_down


def centred_token_shift(p, mu_prev, mu_next):
    zero = jnp.zeros_like(p[:, :1])
    p_prev = jnp.concatenate([zero, p[:, :-1]], axis=1)
    p_next = jnp.concatenate([p[:, 1:], zero], axis=1)
    return p + mu_prev * (p_prev - p) + mu_next * (p_next - p)


def wkv7_scan(r, decay, k, v, kk, b, reverse):
    bsz, _, h, n = r.shape

    def step(S, inp):
        r_t, w_t, k_t, v_t, kk_t, b_t = inp
        sa = jnp.einsum('bhvk,bhk->bhv', S, -kk_t)
        S = S * w_t[:, :, None, :] + sa[..., :, None] * b_t[..., None, :] + v_t[..., :, None] * k_t[..., None, :]
        y = jnp.einsum('bhvk,bhk->bhv', S, r_t)
        return S, y

    xs = tuple(jnp.swapaxes(a.astype(jnp.float32), 0, 1) for a in (r, decay, k, v, kk, b))
    S0 = jnp.zeros((bsz, h, n, n), jnp.float32)
    _, ys = lax.scan(step, S0, xs, reverse=reverse)
    return jnp.swapaxes(ys, 0, 1)


def rwkv7_bidir(p, mu_prev, mu_next, w0_f, w2_f, w0_b, w2_b, a0_f, a2_f, a0_b, a2_b,
                g2, k_k, k_a, r_k, gn_w, gn_b):
    bsz, t, _ = p.shape
    H, N = N_RWKV_HEADS, RWKV_HEAD
    heads = lambda a: a.reshape(bsz, t, H, N)
    p = centred_token_shift(p, mu_prev, mu_next)
    r, k, v, xw, xa, xg = jnp.split(p, list(RWKV_SPLITS), axis=-1)
    hw = jnp.tanh(xw)
    g = jax.nn.sigmoid(xg) @ g2
    kk = heads((k * k_k).astype(jnp.float32))
    kk = kk / jnp.maximum(jnp.linalg.norm(kk, axis=-1, keepdims=True), 1e-12)
    r_h = heads(r).astype(jnp.float32)
    v_h = heads(v).astype(jnp.float32)
    k_h = heads(k).astype(jnp.float32)
    k_a_h = k_a.astype(jnp.float32).reshape(H, N)
    y = jnp.zeros((bsz, t, H, N), jnp.float32)
    k_sum = jnp.zeros((bsz, t, H, N), jnp.float32)
    for w0, w2, a0, a2, rev in ((w0_f, w2_f, a0_f, a2_f, False), (w0_b, w2_b, a0_b, a2_b, True)):
        w = -jax.nn.softplus(-(w0 + hw @ w2)) - 0.5
        decay = jnp.exp(-jnp.exp(w.astype(jnp.float32)))
        a = heads(jax.nn.sigmoid(a0 + xa @ a2).astype(jnp.float32))
        k_dir = k_h * (1.0 + (a - 1.0) * k_a_h)
        y = y + wkv7_scan(r_h, heads(decay), k_dir, v_h, kk, kk * a, rev)
        k_sum = k_sum + k_dir
    mean = jnp.mean(y, axis=-1, keepdims=True)
    var = jnp.mean(jnp.square(y - mean), axis=-1, keepdims=True)
    yn = ((y - mean) * lax.rsqrt(var + RWKV_GN_EPS)).reshape(bsz, t, D_RWKV) * gn_w.astype(jnp.float32) + gn_b.astype(jnp.float32)
    bonus = jnp.sum(r_h * k_sum * r_k.astype(jnp.float32), axis=-1, keepdims=True) * v_h
    out = (yn + bonus.reshape(bsz, t, D_RWKV)) * g.astype(jnp.float32)
    return out.astype(p.dtype)


def diff_attention_alibi(p, lq1, lk1, lq2, lk2, subln_g, lam_init):
    bsz, t, _ = p.shape
    H, d = N_DIFF_HEADS, DIFF_D
    q, k, v = jnp.split(p, 3, axis=-1)
    q = q.reshape(bsz, t, H, 2, d)
    k = k.reshape(bsz, t, H, 2, d)
    v = v.reshape(bsz, t, H, 2 * d)
    lam = (jnp.exp(jnp.sum(lq1.astype(jnp.float32) * lk1.astype(jnp.float32)))
           - jnp.exp(jnp.sum(lq2.astype(jnp.float32) * lk2.astype(jnp.float32))) + lam_init)
    slopes = 2.0 ** (-ALIBI_MAX_EXP * jnp.arange(1, H + 1, dtype=jnp.float32) / H)
    kpos = jnp.arange(t, dtype=jnp.float32)
    scale = d ** -0.5
    nblk = t // Q_BLOCK
    qb = jnp.transpose(q.reshape(bsz, nblk, Q_BLOCK, H, 2, d), (1, 0, 2, 3, 4, 5))

    def block(args):
        q_blk, i = args
        qpos = (i * Q_BLOCK + jnp.arange(Q_BLOCK)).astype(jnp.float32)
        s = jnp.einsum('bqhcd,bkhcd->bchqk', q_blk, k).astype(jnp.float32) * scale
        dist = jnp.abs(qpos[:, None] - kpos[None, :])
        s = s - slopes[:, None, None] * dist[None]
        prob = jax.nn.softmax(s, axis=-1)
        attn = prob[:, 0] - lam * prob[:, 1]
        return jnp.einsum('bhqk,bkhv->bqhv', attn.astype(v.dtype), v)

    ob = lax.map(block, (qb, jnp.arange(nblk)))
    o = jnp.transpose(ob, (1, 0, 2, 3, 4)).reshape(bsz, t, H, 2 * d)
    o = rms_norm(o, subln_g, SUBLN_EPS) * (1.0 - lam_init)
    return o.reshape(bsz, t, D_DIFF)


def setup_inputs(seed: int = 0) -> dict:
    key = jax.random.key(seed)
    ks = iter(jax.random.split(key, 64))
    L, D, F = DEPTH, D_MODEL, D_FF
    nrm = lambda shape, s: s * jax.random.normal(next(ks), shape, jnp.float32)
    gain = lambda n: 1.0 + nrm((L, n), 0.02)
    unif = lambda shape, lo, hi: jax.random.uniform(next(ks), shape, jnp.float32, lo, hi)
    return {
        "x": nrm((BATCH, SEQ, D), 1.0),
        "ffn1_pre_g": gain(D),
        "ffn1_w_gate": nrm((L, D, F), D ** -0.5),
        "ffn1_w_up": nrm((L, D, F), D ** -0.5),
        "ffn1_w_down": nrm((L, F, D), F ** -0.5),
        "ffn1_post_g": gain(D),
        "mix_pre_g": gain(D),
        "w_in": nrm((L, D, D_IN), D ** -0.5),
        "mu_prev": unif((L, RWKV_COLS), 0.0, 0.5),
        "mu_next": unif((L, RWKV_COLS), 0.0, 0.5),
        "w0_f": unif((L, D_RWKV), -7.0, -1.0),
        "w2_f": nrm((L, DECAY_RANK, D_RWKV), 0.1 * DECAY_RANK ** -0.5),
        "w0_b": unif((L, D_RWKV), -7.0, -1.0),
        "w2_b": nrm((L, DECAY_RANK, D_RWKV), 0.1 * DECAY_RANK ** -0.5),
        "a0_f": nrm((L, D_RWKV), 0.1),
        "a2_f": nrm((L, ICLR_RANK, D_RWKV), ICLR_RANK ** -0.5),
        "a0_b": nrm((L, D_RWKV), 0.1),
        "a2_b": nrm((L, ICLR_RANK, D_RWKV), ICLR_RANK ** -0.5),
        "g2": nrm((L, GATE_RANK, D_RWKV), GATE_RANK ** -0.5),
        "k_k": 0.85 + nrm((L, D_RWKV), 0.02),
        "k_a": 1.0 + nrm((L, D_RWKV), 0.02),
        "r_k": nrm((L, N_RWKV_HEADS, RWKV_HEAD), 0.1),
        "gn_w": gain(D_RWKV),
        "gn_b": nrm((L, D_RWKV), 0.02),
        "lq1": nrm((L, DIFF_D), 0.1),
        "lk1": nrm((L, DIFF_D), 0.1),
        "lq2": nrm((L, DIFF_D), 0.1),
        "lk2": nrm((L, DIFF_D), 0.1),
        "subln_g": gain(DIFF_HEAD),
        "w_out": nrm((L, D_MIX, D), D_MIX ** -0.5),
        "mix_post_g": gain(D),
        "ffn2_pre_g": gain(D),
        "ffn2_w_gate": nrm((L, D, F), D ** -0.5),
        "ffn2_w_up": nrm((L, D, F), D ** -0.5),
        "ffn2_w_down": nrm((L, F, D), F ** -0.5),
        "ffn2_post_g": gain(D),
        "final_g": gain(D),
    }


def reference(x, ffn1_pre_g, ffn1_w_gate, ffn1_w_up, ffn1_w_down, ffn1_post_g,
              mix_pre_g, w_in, mu_prev, mu_next, w0_f, w2_f, w0_b, w2_b,
              a0_f, a2_f, a0_b, a2_b, g2, k_k, k_a, r_k, gn_w, gn_b,
              lq1, lk1, lq2, lk2, subln_g, w_out, mix_post_g,
              ffn2_pre_g, ffn2_w_gate, ffn2_w_up, ffn2_w_down, ffn2_post_g, final_g):
    h = x
    for l in range(DEPTH):
        lam_init = 0.8 - 0.6 * math.exp(-0.3 * l)
        f1 = swiglu(rms_norm(h, ffn1_pre_g[l]), ffn1_w_gate[l], ffn1_w_up[l], ffn1_w_down[l])
        h = h + FFN_RESIDUAL * rms_norm(f1, ffn1_post_g[l])
        proj = rms_norm(h, mix_pre_g[l]) @ w_in[l]
        y_a = rwkv7_bidir(proj[..., :RWKV_COLS], mu_prev[l], mu_next[l], w0_f[l], w2_f[l], w0_b[l], w2_b[l],
                          a0_f[l], a2_f[l], a0_b[l], a2_b[l], g2[l], k_k[l], k_a[l], r_k[l], gn_w[l], gn_b[l])
        y_b = diff_attention_alibi(proj[..., RWKV_COLS:], lq1[l], lk1[l], lq2[l], lk2[l], subln_g[l], lam_init)
        mix = jnp.concatenate([y_a, y_b.astype(y_a.dtype)], axis=-1) @ w_out[l]
        h = h + rms_norm(mix, mix_post_g[l])
        f2 = swiglu(rms_norm(h, ffn2_pre_g[l]), ffn2_w_gate[l], ffn2_w_up[l], ffn2_w_down[l])
        h = h + FFN_RESIDUAL * rms_norm(f2, ffn2_post_g[l])
        h = rms_norm(h, final_g[l])
    return h
```

```cpp
#include <hip/hip_runtime.h>
#include <cstdio>
#include <cstdint>

constexpr int T = 8192, D = 4096, FF = 11008, DR = 2048, RC = 6592, RCP = 6656, NIN = 12800, QKVW = 6144, NHR = 32, HN = 64, LK = 256;
constexpr int NDH = 16;
constexpr float NORM_EPS = 1e-6f, GN_EPS = 64e-5f, SUBLN_EPS = 1e-5f, LAM_INIT = 0.2f;
constexpr float QSCALE = 0.125f * 1.4426950408889634f;
#ifndef N_PHASES
#define N_PHASES 14
#endif
#ifndef MK_ONE_LAUNCH
#define MK_ONE_LAUNCH 1
#endif

namespace pg8 {
#define PG8_LAS __attribute__((address_space(3)))
typedef unsigned short bf16_t;
typedef short bf16x8 __attribute__((ext_vector_type(8)));
typedef float f32x4 __attribute__((ext_vector_type(4)));
typedef unsigned u32x4 __attribute__((ext_vector_type(4)));
constexpr int BM = 256, BK = 64, HALF = 128, HTB = HALF * BK * 2  , STAGE_BYTES = 8 * HTB, NXCD = 8, WGM = 8;

__host__ __device__ __forceinline__ int lds_byte(int r, int c) { const int st = (r >> 4) * 2 + (c >> 5), rr = r & 15, cc = c & 31, ob = rr * 64 + cc * 2; return st * 1024 + (ob ^ (((ob >> 9) & 1) << 5)); }
__host__ __device__ __forceinline__ void stage_rc(int b, int& R, int& C) { const int st = b / 1024, sb = b % 1024, swz = sb ^ (((sb >> 9) & 1) << 5); R = (st >> 1) * 16 + swz / 64; C = (st & 1) * 32 + (swz % 64) / 2; }
__host__ __device__ __forceinline__ int perm32(int rho) { const int n = rho >> 4, i = rho & 15; return 8 * (i >> 2) + 4 * n + (i & 3); }

struct Unit { int pm, pn; };
struct Gemm { const bf16_t* A; const bf16_t* Bt; int M, N, K; };

struct StaticOrder {
    int nM, nN, nwg, G, c;
    __host__ __device__ void init(int M, int N, int G_, int c_) { nM = M / BM; nN = N / BM; nwg = nM * nN; G = G_; c = c_; }
    __host__ __device__ bool next(int i, Unit& u) const {
        const long L = (long)i * G + c; if (L >= nwg) return false;
        int wgid = (int)L; { const int q = nwg / NXCD, r = nwg % NXCD, xcd = wgid % NXCD, off = wgid / NXCD; wgid = (xcd < r ? xcd * (q + 1) : r * (q + 1) + (xcd - r) * q) + off; }
        const int nig = WGM * nN, gid = wgid / nig, fm = gid * WGM, gsz = (nM - fm) < WGM ? (nM - fm) : WGM;
        u.pm = fm + ((wgid % nig) % gsz); u.pn = (wgid % nig) / gsz; return true;
    }
    __device__ __forceinline__ void a_ready(const Unit&) const {}
    __device__ __forceinline__ void done(const Unit&) const {}
};

template <int N> __device__ __forceinline__ void wait_vmcnt() { static_assert(N >= 0 && N <= 63, "vmcnt has 6 bits"); asm volatile("s_waitcnt vmcnt(%0)" :: "n"(N) : "memory"); }
__device__ __forceinline__ unsigned cvt_pk_bf16(float lo, float hi) { unsigned r; asm volatile("v_cvt_pk_bf16_f32 %0, %1, %2" : "=v"(r) : "v"(lo), "v"(hi)); return r; }
typedef unsigned u32x2 __attribute__((ext_vector_type(2)));
__device__ __forceinline__ float sigmoid_f(float x) { return __builtin_amdgcn_rcpf(1.0f + __builtin_amdgcn_exp2f(-1.4426950408889634f * x)); }

struct EpiF32 {
    static constexpr bool PERM = false, AFTER_DRAIN = false; static constexpr int NSTORE = 32;
    float* C; int ldc;
    __device__ __forceinline__ void operator()(const f32x4 (&acc)[2][2][4][2], const Unit& u, int wr, int wc, int fr, int fq) const {
        const int row0 = u.pm * BM + wr * 64 + fr, col0 = u.pn * BM + wc * 32 + 4 * fq;
#pragma unroll
        for (int ai = 0; ai < 2; ++ai)
#pragma unroll
            for (int m = 0; m < 4; ++m) { float* rowp = C + (size_t)(row0 + ai * HALF + m * 16) * ldc + col0;
#pragma unroll
                for (int bj = 0; bj < 2; ++bj)
#pragma unroll
                    for (int n = 0; n < 2; ++n) *(f32x4*)(rowp + bj * HALF + n * 16) = acc[ai][bj][m][n]; }
    }
};
struct EpiBf16Out {
    static constexpr bool PERM = true, AFTER_DRAIN = false; static constexpr int NSTORE = 16;
    bf16_t* O; int ldc;
    __device__ __forceinline__ void operator()(const f32x4 (&acc)[2][2][4][2], const Unit& u, int wr, int wc, int fr, int fq) const {
        const int row0 = u.pm * BM + wr * 64 + fr, col0 = u.pn * BM + wc * 32 + 8 * fq;
#pragma unroll
        for (int ai = 0; ai < 2; ++ai)
#pragma unroll
            for (int m = 0; m < 4; ++m) { bf16_t* rowp = O + (size_t)(row0 + ai * HALF + m * 16) * ldc + col0;
#pragma unroll
                for (int bj = 0; bj < 2; ++bj) { const f32x4 v0 = acc[ai][bj][m][0], v1 = acc[ai][bj][m][1];
                    u32x4 w; w.x = cvt_pk_bf16(v0[0], v0[1]); w.y = cvt_pk_bf16(v0[2], v0[3]); w.z = cvt_pk_bf16(v1[0], v1[1]); w.w = cvt_pk_bf16(v1[2], v1[3]);
                    *(u32x4*)(rowp + bj * HALF) = w; } }
    }
};
struct EpiSwiGLU {
    static constexpr bool PERM = true, AFTER_DRAIN = false; static constexpr int NSTORE = 8;
    bf16_t* O; int ldc;
    __device__ __forceinline__ void operator()(const f32x4 (&acc)[2][2][4][2], const Unit& u, int wr, int wc, int fr, int fq) const {
        const int row0 = u.pm * BM + wr * 64 + fr, col0 = u.pn * HALF + wc * 32 + 8 * fq;
#pragma unroll
        for (int ai = 0; ai < 2; ++ai)
#pragma unroll
            for (int m = 0; m < 4; ++m) { bf16_t* rowp = O + (size_t)(row0 + ai * HALF + m * 16) * ldc + col0;
                float v[8];
#pragma unroll
                for (int n = 0; n < 2; ++n)
#pragma unroll
                    for (int j = 0; j < 4; ++j) { const float g = acc[ai][0][m][n][j], up = acc[ai][1][m][n][j]; v[n * 4 + j] = g * sigmoid_f(g) * up; }
                u32x4 w; w.x = cvt_pk_bf16(v[0], v[1]); w.y = cvt_pk_bf16(v[2], v[3]); w.z = cvt_pk_bf16(v[4], v[5]); w.w = cvt_pk_bf16(v[6], v[7]);
                *(u32x4*)rowp = w; }
    }
};
struct EpiIn {
    static constexpr bool PERM = false, AFTER_DRAIN = false; static constexpr int NSTORE = 32;
    bf16_t* PR; bf16_t* QKV; float qs;
    __device__ __forceinline__ void operator()(const f32x4 (&acc)[2][2][4][2], const Unit& u, int wr, int wc, int fr, int fq) const {
        const int row0 = u.pm * BM + wr * 64 + fr; const bool rw = u.pn < 26;
        const int pc = rw ? u.pn : u.pn - 26, col0 = pc * BM + wc * 32 + 4 * fq, ld = rw ? 6656 : 6144; const float s = (!rw && pc < 8) ? qs : 1.0f;
        bf16_t* base = rw ? PR : QKV;
#pragma unroll
        for (int ai = 0; ai < 2; ++ai)
#pragma unroll
            for (int m = 0; m < 4; ++m) { bf16_t* rowp = base + (size_t)(row0 + ai * HALF + m * 16) * ld + col0;
#pragma unroll
                for (int bj = 0; bj < 2; ++bj)
#pragma unroll
                    for (int n = 0; n < 2; ++n) { const f32x4 v = acc[ai][bj][m][n] * s; u32x2 w; w.x = cvt_pk_bf16(v[0], v[1]); w.y = cvt_pk_bf16(v[2], v[3]);
                        *(u32x2*)(rowp + bj * HALF + n * 16) = w; } }
    }
};
template <int MODE> struct EpiLora {
    static constexpr bool PERM = false, AFTER_DRAIN = false; static constexpr int NSTORE = 32;
    void* Of; void* Ob; const float* bf; const float* bb;
    __device__ __forceinline__ void operator()(const f32x4 (&acc)[2][2][4][2], const Unit& u, int wr, int wc, int fr, int fq) const {
        const int row0 = u.pm * BM + wr * 64 + fr; const bool back = u.pn >= 8; const int pc = back ? u.pn - 8 : u.pn, col0 = pc * BM + wc * 32 + 4 * fq;
        void* O = back ? Ob : Of; const float* bias = back ? bb : bf;
#pragma unroll
        for (int bj = 0; bj < 2; ++bj)
#pragma unroll
            for (int n = 0; n < 2; ++n) {
                const f32x4 bv = (MODE == 2) ? (f32x4){0.f, 0.f, 0.f, 0.f} : *(const f32x4*)(bias + col0 + bj * HALF + n * 16);
#pragma unroll
                for (int ai = 0; ai < 2; ++ai)
#pragma unroll
                    for (int m = 0; m < 4; ++m) { const size_t off = (size_t)(row0 + ai * HALF + m * 16) * 2048 + col0 + bj * HALF + n * 16;
                        f32x4 v = acc[ai][bj][m][n] + bv;
                        if (MODE == 0) {
#pragma unroll
                            for (int j = 0; j < 4; ++j) v[j] = __builtin_amdgcn_exp2f(-0.60653065971f * 1.4426950408889634f * sigmoid_f(v[j]));
                            *(f32x4*)((float*)O + off) = v; }
                        else if (MODE == 1) {
#pragma unroll
                                for (int j = 0; j < 4; ++j) v[j] = sigmoid_f(v[j]);
                            *(f32x4*)((float*)O + off) = v; }
                        else {
                            u32x2 w; w.x = cvt_pk_bf16(v[0], v[1]); w.y = cvt_pk_bf16(v[2], v[3]); *(u32x2*)((bf16_t*)O + off) = w; } }
                asm volatile("" ::: "memory"); }
    }
};

template <class Epi, class Sched, bool ALIGN_EPI = false, bool SP2 = false>
__device__ __forceinline__ void gemm_phase(PG8_LAS unsigned char* lds, const Gemm g, const Sched& S, const Epi& E) {
    int tid_ = threadIdx.x; asm volatile("" : "+v"(tid_));
    const int tid = tid_, wid = __builtin_amdgcn_readfirstlane(tid >> 6), lane = tid & 63, wr = wid >> 2, wc = wid & 3, fr = lane & 15, fq = lane >> 4;
    const int K = g.K, nt = K / BK;
    unsigned voffA[2], voffB[2];
#pragma unroll
    for (int i = 0; i < 2; ++i) { int R, C; stage_rc(tid * 16 + i * 8192, R, C); const int Rb = Epi::PERM ? ((R & ~31) + perm32(R & 31)) : R;
        voffA[i] = (unsigned)(R * K + C) * 2u; voffB[i] = (unsigned)(Rb * K + C) * 2u; }
    const size_t kstep = (size_t)(BK * 2);
    const size_t hstep = (size_t)HALF * K * 2;
    const size_t tstep = 2 * hstep;
    const unsigned ldsw = (unsigned)wid * 1024u;
    const int aoff = lds_byte(wr * 64 + fr, fq * 8), boff = lds_byte(wc * 32 + fr, fq * 8);
#define PG8_SA(b, h) (((b) * 2 + (h)) * HTB)
#define PG8_SB(b, h) ((4 + (b) * 2 + (h)) * HTB)
#define PG8_STAGE(bufoff, gbase, voff) do { _Pragma("unroll") for (int _i = 0; _i < 2; ++_i) \
        __builtin_amdgcn_global_load_lds((const unsigned*)((const char*)(gbase) + (voff)[_i]), (PG8_LAS unsigned*)(lds + (bufoff) + ldsw + _i * 8192), 16, 0, 0); } while (0)
#define PG8_LDA(dst, b, h) do { _Pragma("unroll") for (int m = 0; m < 4; ++m) _Pragma("unroll") for (int k = 0; k < 2; ++k) dst[m][k] = *(const PG8_LAS bf16x8*)(lds + PG8_SA(b, h) + aoff + m * 2048 + k * 1024); } while (0)
#define PG8_LDB(dst, b, h) do { _Pragma("unroll") for (int n = 0; n < 2; ++n) _Pragma("unroll") for (int k = 0; k < 2; ++k) dst[n][k] = *(const PG8_LAS bf16x8*)(lds + PG8_SB(b, h) + boff + n * 2048 + k * 1024); } while (0)
#define PG8_MMA(ai, bj, At, Bt) do { __builtin_amdgcn_s_setprio(1); _Pragma("unroll") for (int m = 0; m < 4; ++m) _Pragma("unroll") for (int n = 0; n < 2; ++n) _Pragma("unroll") for (int k = 0; k < 2; ++k) \
        acc[ai][bj][m][n] = __builtin_amdgcn_mfma_f32_16x16x32_bf16(Bt[n][k], At[m][k], acc[ai][bj][m][n], 0, 0, 0); __builtin_amdgcn_s_setprio(0); } while (0)
#define PG8_WAIT_V(n) asm volatile("s_waitcnt vmcnt(" #n ")" ::: "memory")
#define PG8_WAIT_L(n) asm volatile("s_waitcnt lgkmcnt(" #n ")" ::: "memory")
#define PG8_BAR __builtin_amdgcn_s_barrier()
#define PG8_SCHED __builtin_amdgcn_sched_barrier(0)
    Unit cur, nxt; int ui = 0;
    if (!S.next(0, cur)) return;
    f32x4 acc[2][2][4][2];
#pragma unroll
    for (int a = 0; a < 2; ++a)
#pragma unroll
        for (int b = 0; b < 2; ++b)
#pragma unroll
            for (int m = 0; m < 4; ++m)
#pragma unroll
                for (int n = 0; n < 2; ++n) acc[a][b][m][n] = (f32x4){0.f, 0.f, 0.f, 0.f};
    bf16x8 At[4][2], B0[2][2], B1[2][2];
    const char* cA = (const char*)g.A + (size_t)cur.pm * tstep; const char* cB = (const char*)g.Bt + (size_t)cur.pn * tstep;
    S.a_ready(cur);
    if constexpr (SP2) {
        PG8_STAGE(PG8_SB(0, 0), cB, voffB); PG8_STAGE(PG8_SB(0, 1), cB + hstep, voffB); PG8_STAGE(PG8_SA(0, 0), cA, voffA); PG8_STAGE(PG8_SA(0, 1), cA + hstep, voffA);
        if (wr == 1) PG8_BAR;
        PG8_WAIT_V(2); PG8_BAR;
        PG8_STAGE(PG8_SB(1, 0), cB + kstep, voffB); PG8_STAGE(PG8_SA(1, 0), cA + kstep, voffA); PG8_STAGE(PG8_SB(1, 1), cB + hstep + kstep, voffB);
        PG8_WAIT_V(6); PG8_BAR;
    } else {
        PG8_STAGE(PG8_SB(0, 0), cB, voffB); PG8_STAGE(PG8_SA(0, 0), cA, voffA); PG8_STAGE(PG8_SB(0, 1), cB + hstep, voffB); PG8_STAGE(PG8_SA(0, 1), cA + hstep, voffA);
        if (wr == 1) PG8_BAR;
        PG8_WAIT_V(4); PG8_BAR;
        PG8_STAGE(PG8_SB(1, 0), cB + kstep, voffB); PG8_STAGE(PG8_SA(1, 0), cA + kstep, voffA); PG8_STAGE(PG8_SB(1, 1), cB + hstep + kstep, voffB);
        PG8_WAIT_V(6); PG8_BAR;
    }
    for (;;) {
        const bool has_next = S.next(ui + 1, nxt);
        const char* nA = has_next ? (const char*)g.A + (size_t)nxt.pm * tstep : cA; const char* nB = has_next ? (const char*)g.Bt + (size_t)nxt.pn * tstep : cB;
_Pragma("unroll 1")
        for (int t = 0; t < nt; t += 2) {
            const bool last = (t == nt - 2), after_epi = (t == 0) && (ui > 0);
            const char* a1 = cA + (size_t)(t + 1) * kstep;
            const char* a2 = last ? nA : cA + (size_t)(t + 2) * kstep; const char* b2 = last ? nB : cB + (size_t)(t + 2) * kstep;
            const char* a3 = a2 + kstep; const char* b3 = b2 + kstep;
            if (last && has_next) S.a_ready(nxt);
            if constexpr (SP2) {
            PG8_LDB(B0, 0, 0); PG8_LDB(B1, 0, 1); PG8_SCHED; PG8_LDA(At, 0, 0); PG8_STAGE(PG8_SA(1, 1), a1 + hstep, voffA);
            if (after_epi) wait_vmcnt<8 + Epi::NSTORE>(); else PG8_WAIT_V(8);
            PG8_WAIT_L(0); PG8_BAR; PG8_MMA(0, 0, At, B0); PG8_MMA(0, 1, At, B1); PG8_BAR; PG8_SCHED;
            PG8_LDA(At, 0, 1); PG8_STAGE(PG8_SB(0, 0), b2, voffB); PG8_STAGE(PG8_SB(0, 1), b2 + hstep, voffB); PG8_STAGE(PG8_SA(0, 0), a2, voffA);
            if (after_epi) wait_vmcnt<8 + Epi::NSTORE>(); else PG8_WAIT_V(8);
            PG8_WAIT_L(0); PG8_BAR; PG8_MMA(1, 0, At, B0); PG8_MMA(1, 1, At, B1); PG8_BAR; PG8_SCHED;
            PG8_LDB(B0, 1, 0); PG8_LDB(B1, 1, 1); PG8_SCHED; PG8_LDA(At, 1, 0); PG8_STAGE(PG8_SA(0, 1), a2 + hstep, voffA);
            PG8_WAIT_V(8); PG8_WAIT_L(0); PG8_BAR; PG8_MMA(0, 0, At, B0); PG8_MMA(0, 1, At, B1); PG8_BAR; PG8_SCHED;
            PG8_LDA(At, 1, 1); PG8_STAGE(PG8_SB(1, 0), b3, voffB); PG8_STAGE(PG8_SB(1, 1), b3 + hstep, voffB); PG8_STAGE(PG8_SA(1, 0), a3, voffA);
            PG8_WAIT_V(8); PG8_WAIT_L(0); PG8_BAR; PG8_MMA(1, 0, At, B0); PG8_MMA(1, 1, At, B1); PG8_BAR; PG8_SCHED;
            } else {
            PG8_LDB(B0, 0, 0); PG8_SCHED; PG8_LDA(At, 0, 0); PG8_STAGE(PG8_SA(1, 1), a1 + hstep, voffA);
            PG8_WAIT_L(8); PG8_BAR; PG8_WAIT_L(0); PG8_MMA(0, 0, At, B0); PG8_BAR; PG8_SCHED;
            PG8_LDB(B1, 0, 1); PG8_STAGE(PG8_SB(0, 0), b2, voffB);
            PG8_BAR; PG8_WAIT_L(0); PG8_MMA(0, 1, At, B1); PG8_BAR;
            PG8_LDA(At, 0, 1); PG8_STAGE(PG8_SA(0, 0), a2, voffA);
            PG8_BAR; PG8_WAIT_L(0); PG8_MMA(1, 0, At, B0); PG8_BAR; PG8_SCHED;
            PG8_STAGE(PG8_SB(0, 1), b2 + hstep, voffB);
            PG8_WAIT_V(6); PG8_BAR; PG8_MMA(1, 1, At, B1); PG8_BAR;
            PG8_LDB(B0, 1, 0); PG8_SCHED; PG8_LDA(At, 1, 0); PG8_STAGE(PG8_SA(0, 1), a2 + hstep, voffA);
            PG8_WAIT_L(8); PG8_BAR; PG8_WAIT_L(0); PG8_MMA(0, 0, At, B0); PG8_BAR; PG8_SCHED;
            PG8_LDB(B1, 1, 1); PG8_STAGE(PG8_SB(1, 0), b3, voffB);
            PG8_BAR; PG8_WAIT_L(0); PG8_MMA(0, 1, At, B1); PG8_BAR;
            PG8_LDA(At, 1, 1); PG8_STAGE(PG8_SA(1, 0), a3, voffA);
            PG8_BAR; PG8_WAIT_L(0); PG8_MMA(1, 0, At, B0); PG8_BAR; PG8_SCHED;
            PG8_STAGE(PG8_SB(1, 1), b3 + hstep, voffB);
            PG8_WAIT_V(6); PG8_BAR; PG8_MMA(1, 1, At, B1); PG8_BAR;
            }
        }
        if constexpr (ALIGN_EPI) { if (wr == 0) PG8_BAR; }
        if constexpr (!Epi::AFTER_DRAIN) { E(acc, cur, wr, wc, fr, fq); S.done(cur); }
        if (!has_next) break;
#pragma unroll
        for (int a = 0; a < 2; ++a)
#pragma unroll
            for (int b = 0; b < 2; ++b)
#pragma unroll
                for (int m = 0; m < 4; ++m)
#pragma unroll
                    for (int n = 0; n < 2; ++n) acc[a][b][m][n] = (f32x4){0.f, 0.f, 0.f, 0.f};
        cur = nxt; cA = nA; cB = nB; ++ui;
        if constexpr (ALIGN_EPI) { if (wr == 1) PG8_BAR; }
    }
    PG8_WAIT_V(0);
    if constexpr (!ALIGN_EPI) { if (wr == 0) PG8_BAR; }
    PG8_BAR;
    if constexpr (Epi::AFTER_DRAIN) { E.fused(acc, cur, wr, wc, fr, fq, lds, wid, lane); S.done(cur); }
#undef PG8_SA
#undef PG8_SB
#undef PG8_STAGE
#undef PG8_LDA
#undef PG8_LDB
#undef PG8_MMA
#undef PG8_WAIT_V
#undef PG8_WAIT_L
#undef PG8_BAR
#undef PG8_SCHED
}
}

constexpr size_t MiB = 1u << 20;
constexpr size_t WS_CTL = 0, CTL_ZERO_BYTES = 1 * MiB;
constexpr size_t WS_WGU = 1 * MiB, WS_WD = 173 * MiB;
constexpr size_t WS_WIN = 259 * MiB, WS_WOUT = 359 * MiB;
constexpr int TAIL_WD = 9216, TAIL_GU = 12288, TAIL_WD2 = 9216;
constexpr size_t WS_W2T = 391 * MiB, WS_A2T = 393 * MiB, WS_G2T = 395 * MiB;
constexpr size_t WS_XN = 396 * MiB;
constexpr size_t WS_HID = 460 * MiB;
constexpr size_t WS_F = 632 * MiB;
constexpr size_t WS_H = 760 * MiB;
constexpr size_t WS_X1 = 888 * MiB;
constexpr size_t WS_WGU2 = 1208 * MiB, WS_WD2 = WS_WIN;
constexpr size_t WS_END = 1380 * MiB;
constexpr size_t WS_R = 1 * MiB, WS_K = 65 * MiB, WS_V = 129 * MiB, WS_KK = 193 * MiB;
constexpr size_t WS_QKV = WS_HID, WS_YF = WS_HID + 96 * MiB, WS_HW = WS_HID + 160 * MiB, WS_XA = WS_HID + 164 * MiB, WS_SG = WS_HID + 168 * MiB;
constexpr size_t WS_YB = WS_F, WS_O1 = WS_F + 64 * MiB;
constexpr size_t WS_BONF = WS_HW, WS_BONB = WS_HW + 2 * MiB;
constexpr size_t WS_PR = WS_X1, WS_DECF = WS_X1, WS_DECB = WS_X1 + 64 * MiB, WS_AF = WS_X1 + 128 * MiB, WS_AB = WS_X1 + 192 * MiB, WS_G = WS_X1 + 256 * MiB;

constexpr int NWAVES = 8;
constexpr int RING_OFF = 0, RING_BYTES = 131072;
constexpr int LDSCTL_OFF = RING_BYTES, MISC_OFF = 146944;
constexpr int LDS_BYTES = 147456;

#define GAS __attribute__((address_space(1)))
#define LAS __attribute__((address_space(3)))
typedef unsigned short bf16;
typedef unsigned v4u __attribute__((ext_vector_type(4)));
typedef unsigned v2u __attribute__((ext_vector_type(2)));
typedef float f32x4 __attribute__((ext_vector_type(4)));
typedef float f32x2 __attribute__((ext_vector_type(2)));
typedef short bf16x8 __attribute__((ext_vector_type(8)));
typedef GAS unsigned gu32;
#define RLX_AGENT __ATOMIC_RELAXED, __HIP_MEMORY_SCOPE_AGENT
#define LDS_WAIT() asm volatile("s_waitcnt lgkmcnt(0)" ::: "memory")
#define VM_WAIT() asm volatile("s_waitcnt vmcnt(0)" ::: "memory")
__device__ __forceinline__ unsigned pk2(float lo, float hi) { unsigned r; asm volatile("v_cvt_pk_bf16_f32 %0, %1, %2" : "=v"(r) : "v"(lo), "v"(hi)); return r; }
__device__ __forceinline__ float sigm(float x) { return __builtin_amdgcn_rcpf(1.0f + __builtin_amdgcn_exp2f(-1.4426950408889634f * x)); }
#define XB_TMO      128
#define XB_XCNT(j)  (256  + 64 * (j))
#define XB_XSUB(j)  (1280 + 64 * (j))
#define XB_XGEN(j)  (2304 + 64 * (j))
#define XB_TOP      3328
#define XB_TOPGEN   3392
#define XCD_BAR_WORDS 3456
#define XB_SPIN_CAP (1u << 18)

__device__ __forceinline__ unsigned xb_ld(unsigned* p)              { return __hip_atomic_load(p, __ATOMIC_RELAXED, __HIP_MEMORY_SCOPE_AGENT); }
__device__ __forceinline__ unsigned xb_add(unsigned* p, unsigned v) { return __hip_atomic_fetch_add(p, v, __ATOMIC_RELAXED, __HIP_MEMORY_SCOPE_AGENT); }
__device__ __forceinline__ unsigned xb_xcc_id() { return (unsigned)__builtin_amdgcn_s_getreg((3 << 11) | 20) & 0xFu; }
#define XB_SPIN(cond, bar) do { unsigned _sp = 0; while (cond) { __builtin_amdgcn_s_sleep(1); \
    if ((++_sp & 255u) == 0u) { if (xb_ld(&(bar)[XB_TMO])) break; if (_sp > XB_SPIN_CAP) { atomicAdd(&(bar)[XB_TMO], 1u); break; } } } } while (0)

struct XcdBarrier {
    unsigned* bar; unsigned x;
    volatile LAS unsigned* st;
};

__device__ __forceinline__ XcdBarrier xcd_barrier_post(unsigned* bar, volatile LAS unsigned* st) {
    XcdBarrier b; b.bar = bar; b.x = xb_xcc_id(); b.st = st;
    if (threadIdx.x == 0) (void)xb_add(&bar[XB_XCNT(b.x)], 1u);
    return b;
}
__device__ __forceinline__ void xcd_barrier_complete(unsigned* bar, unsigned x, unsigned& nloc, unsigned& nx) {
    const unsigned G = gridDim.x * gridDim.y * gridDim.z;
    unsigned sum, cnt, mine, sp = 0u;
    for (;;) {
        sum = 0u; cnt = 0u; mine = 0u;
#pragma unroll
        for (unsigned j = 0; j < 16; ++j) { const unsigned c = xb_ld(&bar[XB_XCNT(j)]); sum += c; cnt += (c > 0u) ? 1u : 0u; mine = (j == x) ? c : mine; }
        if (sum == G) break;
        __builtin_amdgcn_s_sleep(1);
        if ((++sp & 255u) == 0u) { if (xb_ld(&bar[XB_TMO])) break; if (sp > XB_SPIN_CAP) { atomicAdd(&bar[XB_TMO], 1u); break; } }
    }
    nloc = mine > 0u ? mine : 1u; nx = cnt > 0u ? cnt : 1u;
}

__device__ __forceinline__ void xcd_barrier(const XcdBarrier& b) {
    asm volatile("s_waitcnt vmcnt(0)" ::: "memory");
    __syncthreads();
    if (threadIdx.x == 0) {
        unsigned* bar = b.bar;
        __builtin_amdgcn_s_waitcnt(0);
        unsigned nloc = b.st[0], nx = b.st[1];
        if (nloc == 0u) { xcd_barrier_complete(bar, b.x, nloc, nx); b.st[0] = nloc; b.st[1] = nx; }
        const unsigned old = xb_add(&bar[XB_XSUB(b.x)], 1u);
        const unsigned gen = old / nloc;
        if (old + 1u == (gen + 1u) * nloc) {
            __builtin_amdgcn_fence(__ATOMIC_RELEASE, "agent");
            asm volatile("s_waitcnt vmcnt(0)" ::: "memory");
            const unsigned og = xb_add(&bar[XB_TOP], 1u);
            const unsigned tg = og / nx;
            if (og + 1u == (tg + 1u) * nx) xb_add(&bar[XB_TOPGEN], 1u);
            else XB_SPIN(xb_ld(&bar[XB_TOPGEN]) == tg, bar);
            __builtin_amdgcn_fence(__ATOMIC_ACQUIRE, "agent");
            xb_add(&bar[XB_XGEN(b.x)], 1u);
            asm volatile("s_waitcnt vmcnt(0)" ::: "memory");
        } else {
            XB_SPIN(xb_ld(&bar[XB_XGEN(b.x)]) == gen, bar);
            __builtin_amdgcn_fence(__ATOMIC_ACQUIRE, "agent");
            asm volatile("s_waitcnt vmcnt(0)" ::: "memory");
        }
    }
    __syncthreads();
}

__device__ __forceinline__ float wave_sum(float v) {
#pragma unroll
    for (int o = 1; o < 64; o <<= 1) v += __shfl_xor(v, o);
    return v;
}
template <int N> __device__ __forceinline__ float dpp_ror(float x) { return __int_as_float(__builtin_amdgcn_update_dpp(0, __float_as_int(x), 0x120 + N, 0xf, 0xf, false)); }
__device__ __forceinline__ float row16_sum(float x) { x += dpp_ror<8>(x); x += dpp_ror<4>(x); x += dpp_ror<2>(x); x += dpp_ror<1>(x); return x; }
__device__ __forceinline__ float sum4(f32x4 v) { return (v.x + v.y) + (v.z + v.w); }
__device__ __forceinline__ float dot4(f32x4 a, f32x4 b) { return (a.x * b.x + a.y * b.y) + (a.z * b.z + a.w * b.w); }
__device__ __forceinline__ float ld_sc1(const float* p) { return __hip_atomic_load(p, __ATOMIC_RELAXED, __HIP_MEMORY_SCOPE_AGENT); }

__device__ __forceinline__ void transpose_item(const float* W, int K, int N, bf16* WT, int dst_row0, LAS float* scr, int k0, int n0, int lane) {
    const float* src = W + (size_t)(k0 + (lane >> 3)) * N + n0 + 4 * (lane & 7);
    f32x4 v[8];
#pragma unroll
    for (int i = 0; i < 8; ++i) v[i] = *(const GAS f32x4*)(src + (size_t)(8 * i) * N);
#pragma unroll
    for (int i = 0; i < 8; ++i) { LAS float* d = scr + (8 * i + (lane >> 3)) * 33 + 4 * (lane & 7); d[0] = v[i].x; d[1] = v[i].y; d[2] = v[i].z; d[3] = v[i].w; }
    LDS_WAIT(); asm volatile("" ::: "memory");
    const int c = lane & 7;
#pragma unroll
    for (int j = 0; j < 4; ++j) { const int n = (lane >> 3) + 8 * j; const LAS float* s = scr + (8 * c) * 33 + n;
        v4u o; o.x = pk2(s[0 * 33], s[1 * 33]); o.y = pk2(s[2 * 33], s[3 * 33]); o.z = pk2(s[4 * 33], s[5 * 33]); o.w = pk2(s[6 * 33], s[7 * 33]);
        *(GAS v4u*)(WT + (size_t)(dst_row0 + n) * K + k0 + 8 * c) = o; }
    LDS_WAIT(); asm volatile("" ::: "memory");
}
template <int MAP> __device__ __forceinline__ void conv_mat(const float* W, int K, int N, bf16* WT, LAS float* scr, int gw, int NGW, int lane, int it_lo = 0, int it_hi = 0x7fffffff) {
    const int nblk = N / 32, nall = (K / 64) * nblk, nitems = nall < it_hi ? nall : it_hi;
    int it = it_lo + gw;
    if (it >= nitems) return;
    const int last = it + ((nitems - 1 - it) / NGW) * NGW;
    f32x4 va[8], vb[8], vc[8], vd[8];
#define CM_LOAD(V, IT) do { const int i_ = (IT) < last ? (IT) : last; const int kb_ = i_ / nblk, nb_ = i_ - kb_ * nblk; \
        const float* src_ = W + (size_t)(64 * kb_ + (lane >> 3)) * N + 32 * nb_ + 4 * (lane & 7); \
        _Pragma("unroll") for (int i = 0; i < 8; ++i) V[i] = *(const GAS f32x4*)(src_ + (size_t)(8 * i) * N); } while (0)
#define CM_STORE(V, IT) do { const int kb_ = (IT) / nblk, nb_ = (IT) - kb_ * nblk, n0_ = 32 * nb_, k0_ = 64 * kb_; int dr_ = n0_; \
        if (MAP == 1) dr_ = 256 * (n0_ >> 7) + (n0_ & 127); \
        if (MAP == 2) dr_ = 256 * (n0_ >> 7) + 128 + (n0_ & 127); \
        if (MAP == 3) dr_ = n0_ < RC ? n0_ : n0_ + (RCP - RC); \
        _Pragma("unroll") for (int i = 0; i < 8; ++i) { LAS float* d_ = scr + (8 * i + (lane >> 3)) * 33 + 4 * (lane & 7); d_[0] = V[i].x; d_[1] = V[i].y; d_[2] = V[i].z; d_[3] = V[i].w; } \
        LDS_WAIT(); asm volatile("" ::: "memory"); \
        _Pragma("unroll") for (int j = 0; j < 4; ++j) { const int n_ = (lane >> 3) + 8 * j; const LAS float* s_ = scr + (8 * (lane & 7)) * 33 + n_; \
            v4u o_; o_.x = pk2(s_[0 * 33], s_[1 * 33]); o_.y = pk2(s_[2 * 33], s_[3 * 33]); o_.z = pk2(s_[4 * 33], s_[5 * 33]); o_.w = pk2(s_[6 * 33], s_[7 * 33]); \
            *(GAS v4u*)(WT + (size_t)(dr_ + n_) * K + k0_ + 8 * (lane & 7)) = o_; } \
        LDS_WAIT(); asm volatile("" ::: "memory"); } while (0)
    CM_LOAD(va, it); CM_LOAD(vb, it + NGW); CM_LOAD(vc, it + 2 * NGW);
    for (; it <= last; it += 4 * NGW) {
        CM_LOAD(vd, it + 3 * NGW); CM_STORE(va, it);
        CM_LOAD(va, it + 4 * NGW); if (it + NGW <= last) CM_STORE(vb, it + NGW);
        CM_LOAD(vb, it + 5 * NGW); if (it + 2 * NGW <= last) CM_STORE(vc, it + 2 * NGW);
        CM_LOAD(vc, it + 6 * NGW); if (it + 3 * NGW <= last) CM_STORE(vd, it + 3 * NGW);
    }
#undef CM_LOAD
#undef CM_STORE
}
__device__ __forceinline__ void conv_lora96(const float* Wf, const float* Wb, bf16* WT, int gtid, int NT_) {
    for (int i = gtid; i < 4096 * 32; i += NT_) { const int n = i & 4095, k8 = i >> 12; const float* W = n < 2048 ? Wf : Wb; const int nn = n & 2047;
        v4u o = {0u, 0u, 0u, 0u};
        if (k8 < 12) { float v[8];
#pragma unroll
            for (int j = 0; j < 8; ++j) v[j] = W[(size_t)(8 * k8 + j) * 2048 + nn];
            o.x = pk2(v[0], v[1]); o.y = pk2(v[2], v[3]); o.z = pk2(v[4], v[5]); o.w = pk2(v[6], v[7]); }
        *(GAS v4u*)(WT + (size_t)n * 256 + 8 * k8) = o; }
}

template <typename Tv> __device__ __forceinline__ Tv gld(const void* base, unsigned off) { return *(const GAS Tv*)((const GAS char*)base + off); }
template <typename Tv> __device__ __forceinline__ void gst(void* base, unsigned off, Tv v) { *(GAS Tv*)((GAS char*)base + off) = v; }
__device__ __forceinline__ void row_norm_bf16(const float* xrow, const float* g, bf16* orow, LAS f32x4* rowbuf, int lane) {
    const unsigned l16 = (unsigned)lane * 16u, l8 = (unsigned)lane * 8u;
    float s = 0.f;
#pragma unroll 8
    for (int j = 0; j < 16; ++j) { const f32x4 v = gld<f32x4>(xrow, l16 + 1024u * j); rowbuf[lane + 64 * j] = v; s += dot4(v, v); }
    const float rstd = 1.0f / sqrtf(wave_sum(s) * (1.0f / D) + NORM_EPS);
#pragma unroll 8
    for (int j = 0; j < 16; ++j) { const f32x4 gg = gld<f32x4>(g, l16 + 1024u * j); const f32x4 o = rowbuf[lane + 64 * j] * rstd * gg; v2u w; w.x = pk2(o.x, o.y); w.y = pk2(o.z, o.w); gst<v2u>(orow, l8 + 512u * j, w); }
}
__device__ __forceinline__ f32x4 bf4_to_f32(v2u w) { return (f32x4){__uint_as_float(w.x << 16), __uint_as_float(w.x & 0xffff0000u), __uint_as_float(w.y << 16), __uint_as_float(w.y & 0xffff0000u)}; }
__device__ __forceinline__ v2u f32_to_bf4(f32x4 o) { v2u w; w.x = pk2(o.x, o.y); w.y = pk2(o.z, o.w); return w; }
template <bool LAST, bool BASE_F32> __device__ __forceinline__ void row_res_norm(const bf16* frow, const void* baserow, float scale, const float* ga, const float* gb, bf16* hrow, bf16* xnrow, float* outrow, LAS f32x4* rowbuf, int lane) {
    const unsigned l16 = (unsigned)lane * 16u, l8 = (unsigned)lane * 8u;
    float s = 0.f;
#pragma unroll 8
    for (int j = 0; j < 16; ++j) { const f32x4 v = bf4_to_f32(gld<v2u>(frow, l8 + 512u * j)); rowbuf[lane + 64 * j] = v; s += dot4(v, v); }
    const float rf = scale / sqrtf(wave_sum(s) * (1.0f / D) + NORM_EPS);
    float s2 = 0.f;
#pragma unroll 8
    for (int j = 0; j < 16; ++j) { const f32x4 b = BASE_F32 ? gld<f32x4>(baserow, l16 + 1024u * j) : bf4_to_f32(gld<v2u>(baserow, l8 + 512u * j)), g = gld<f32x4>(ga, l16 + 1024u * j);
        f32x4 h = b + rowbuf[lane + 64 * j] * rf * g;
        if (!LAST) { const v2u hw = f32_to_bf4(h); gst<v2u>(hrow, l8 + 512u * j, hw); h = bf4_to_f32(hw); }
        rowbuf[lane + 64 * j] = h; s2 += dot4(h, h); }
    const float rh = 1.0f / sqrtf(wave_sum(s2) * (1.0f / D) + NORM_EPS);
#pragma unroll 8
    for (int j = 0; j < 16; ++j) { const f32x4 g = gld<f32x4>(gb, l16 + 1024u * j); const f32x4 o = rowbuf[lane + 64 * j] * rh * g;
        if (LAST) gst<f32x4>(outrow, l16 + 1024u * j, o);
        else gst<v2u>(xnrow, l8 + 512u * j, f32_to_bf4(o)); }
}

__device__ __forceinline__ void unpack8(v4u w, f32x4& a, f32x4& b) { a = (f32x4){__uint_as_float(w.x << 16), __uint_as_float(w.x & 0xffff0000u), __uint_as_float(w.y << 16), __uint_as_float(w.y & 0xffff0000u)};
    b = (f32x4){__uint_as_float(w.z << 16), __uint_as_float(w.z & 0xffff0000u), __uint_as_float(w.w << 16), __uint_as_float(w.w & 0xffff0000u)}; }
__device__ __forceinline__ v4u pack8(f32x4 a, f32x4 b) { v4u w; w.x = pk2(a.x, a.y); w.y = pk2(a.z, a.w); w.z = pk2(b.x, b.y); w.w = pk2(b.z, b.w); return w; }
__device__ __forceinline__ void rr_load16(v4u (&r)[8], const bf16* row, unsigned l16) {
#pragma unroll
    for (int j = 0; j < 8; ++j) r[j] = gld<v4u>(row, l16 + 1024u * j); }
__device__ __forceinline__ void rr_loadx(f32x4 (&x)[16], const float* row, unsigned l32) {
#pragma unroll
    for (int j = 0; j < 8; ++j) { x[2 * j] = gld<f32x4>(row, l32 + 2048u * j); x[2 * j + 1] = gld<f32x4>(row, l32 + 2048u * j + 16u); } }
template <bool LAST, bool BASE_F32> __device__ __forceinline__ void rr_process(const v4u (&f)[8], const v4u (&b)[8], f32x4 (&x)[16], const float* xnext, float scale, const LAS f32x4* gal, const LAS f32x4* gbl,
                                                                               bf16* hrow, bf16* xnrow, float* outrow, int lane) {
    const unsigned l16 = (unsigned)lane * 16u, l32 = (unsigned)lane * 32u;
    float s = 0.f;
#pragma unroll
    for (int j = 0; j < 8; ++j) { f32x4 f0, f1; unpack8(f[j], f0, f1); s += dot4(f0, f0) + dot4(f1, f1); }
    const float rf = scale / sqrtf(wave_sum(s) * (1.0f / D) + NORM_EPS);
    float s2 = 0.f; v4u hb[8];
#pragma unroll
    for (int j = 0; j < 8; ++j) { f32x4 f0, f1, b0, b1; unpack8(f[j], f0, f1);
        if (BASE_F32) { b0 = x[2 * j]; b1 = x[2 * j + 1]; } else unpack8(b[j], b0, b1);
        const f32x4 g0 = gal[2 * lane + 128 * j], g1 = gal[2 * lane + 128 * j + 1];
        f32x4 h0 = b0 + f0 * rf * g0, h1 = b1 + f1 * rf * g1;
        if (!LAST) { const v4u hw = pack8(h0, h1); gst<v4u>(hrow, l16 + 1024u * j, hw); if (BASE_F32) hb[j] = hw; unpack8(hw, h0, h1); }
        s2 += dot4(h0, h0) + dot4(h1, h1); __builtin_amdgcn_sched_barrier(0); }
    if (BASE_F32) rr_loadx(x, xnext, l32);
    const float rh = 1.0f / sqrtf(wave_sum(s2) * (1.0f / D) + NORM_EPS);
#pragma unroll
    for (int j = 0; j < 8; ++j) { f32x4 h0, h1;
        if (BASE_F32) unpack8(hb[j], h0, h1);
        else { f32x4 f0, f1, b0, b1; unpack8(f[j], f0, f1); unpack8(b[j], b0, b1); const f32x4 g0 = gal[2 * lane + 128 * j], g1 = gal[2 * lane + 128 * j + 1];
            h0 = b0 + f0 * rf * g0; h1 = b1 + f1 * rf * g1; if (!LAST) unpack8(pack8(h0, h1), h0, h1); }
        const f32x4 g0 = gbl[2 * lane + 128 * j], g1 = gbl[2 * lane + 128 * j + 1];
        const f32x4 o0 = h0 * rh * g0, o1 = h1 * rh * g1;
        if (LAST) { gst<f32x4>(outrow, l32 + 2048u * j, o0); gst<f32x4>(outrow, l32 + 2048u * j + 16u, o1); }
        else gst<v4u>(xnrow, l16 + 1024u * j, pack8(o0, o1));
        __builtin_amdgcn_sched_barrier(0); }
}
template <bool LAST, bool BASE_F32> __device__ __forceinline__ void rr_phase(LAS unsigned char* ldsb, const bf16* F, const void* base, float scale, const float* ga, const float* gb, bf16* H, bf16* XNo, float* out,
                                                                             int gw, int NGW, int tid, int lane) {
    LAS f32x4* gal = (LAS f32x4*)ldsb; LAS f32x4* gbl = gal + 1024;
    __syncthreads();
    for (int i = tid; i < 1024; i += NWAVES * 64) { gal[i] = ((const GAS f32x4*)ga)[i]; gbl[i] = ((const GAS f32x4*)gb)[i]; }
    __syncthreads();
    const unsigned l16 = (unsigned)lane * 16u, l32 = (unsigned)lane * 32u;
    int m = gw; if (m >= T) return;
    v4u fA[8], fB[8], bA[8] = {}, bB[8] = {}; f32x4 x[16] = {};
    const bf16* B16 = (const bf16*)base; const float* BX = (const float*)base;
    rr_load16(fA, F + (size_t)m * D, l16);
    if (BASE_F32) rr_loadx(x, BX + (size_t)m * D, l32); else rr_load16(bA, B16 + (size_t)m * D, l16);
#pragma unroll 1
    for (; m < T; m += 2 * NGW) {
        const int m1 = m + NGW, m1c = m1 < T ? m1 : m, m2 = m + 2 * NGW, m2c = m2 < T ? m2 : m;
        rr_load16(fB, F + (size_t)m1c * D, l16); if (!BASE_F32) rr_load16(bB, B16 + (size_t)m1c * D, l16);
        rr_process<LAST, BASE_F32>(fA, bA, x, BX + (size_t)m1c * D, scale, gal, gbl, H + (size_t)m * D, XNo + (size_t)m * D, out + (size_t)m * D, lane);
        rr_load16(fA, F + (size_t)m2c * D, l16); if (!BASE_F32) rr_load16(bA, B16 + (size_t)m2c * D, l16);
        if (m1 < T) rr_process<LAST, BASE_F32>(fB, bB, x, BX + (size_t)m2c * D, scale, gal, gbl, H + (size_t)m1 * D, XNo + (size_t)m1 * D, out + (size_t)m1 * D, lane);
    }
}

struct PrepA { const bf16* PR; const float* mu_prev; const float* mu_next; const float* k_k; bf16* R; bf16* K; bf16* V; bf16* KK; bf16* HW; bf16* XA; bf16* SG; };
__device__ __forceinline__ void prep_a_row(const PrepA& P, int t, int lane) {
    const bf16* cur = P.PR + (size_t)t * RCP; const bool hp = t > 0, hn = t < T - 1;
    const bf16* prv = cur - RCP; const bf16* nxt = cur + RCP;
#pragma unroll 2
    for (int j = 0; j < 26; ++j) {
        const int c0 = 4 * lane + 256 * j;
        if (c0 < RC) {
            const f32x4 c = bf4_to_f32(*(const GAS v2u*)(cur + c0));
            const f32x4 pv = hp ? bf4_to_f32(*(const GAS v2u*)(prv + c0)) : (f32x4){0.f, 0.f, 0.f, 0.f};
            const f32x4 nv = hn ? bf4_to_f32(*(const GAS v2u*)(nxt + c0)) : (f32x4){0.f, 0.f, 0.f, 0.f};
            const f32x4 mp = *(const GAS f32x4*)(P.mu_prev + c0), mn = *(const GAS f32x4*)(P.mu_next + c0);
            const f32x4 p = c + mp * (pv - c) + mn * (nv - c);
            if (j < 8) { *(GAS v2u*)(P.R + (size_t)t * DR + c0) = f32_to_bf4(p); }
            else if (j < 16) { const int cc = c0 - 2048; *(GAS v2u*)(P.K + (size_t)t * DR + cc) = f32_to_bf4(p);
                const f32x4 kv = p * *(const GAS f32x4*)(P.k_k + cc); const float ss = row16_sum(dot4(kv, kv));
                const float inv = 1.0f / fmaxf(sqrtf(ss), 1e-12f); *(GAS v2u*)(P.KK + (size_t)t * DR + cc) = f32_to_bf4(kv * inv); }
            else if (j < 24) { *(GAS v2u*)(P.V + (size_t)t * DR + (c0 - 4096)) = f32_to_bf4(p); }
            else if (c0 < 6240) { v2u w; w.x = pk2(tanhf(p.x), tanhf(p.y)); w.y = pk2(tanhf(p.z), tanhf(p.w)); *(GAS v2u*)(P.HW + (size_t)t * LK + (c0 - 6144)) = w; }
            else if (c0 < 6336) { v2u w; w.x = pk2(p.x, p.y); w.y = pk2(p.z, p.w); *(GAS v2u*)(P.XA + (size_t)t * LK + (c0 - 6240)) = w; }
            else { v2u w; w.x = pk2(sigm(p.x), sigm(p.y)); w.y = pk2(sigm(p.z), sigm(p.w)); *(GAS v2u*)(P.SG + (size_t)t * LK + (c0 - 6336)) = w; }
        }
    }
    if (lane < 40) { const v2u z = {0u, 0u}; *(GAS v2u*)(P.HW + (size_t)t * LK + 96 + 4 * lane) = z; *(GAS v2u*)(P.XA + (size_t)t * LK + 96 + 4 * lane) = z; }
}

__device__ __forceinline__ float sum8_lanes(float x) {
    x += __int_as_float(__builtin_amdgcn_update_dpp(0, __float_as_int(x), 0xB1, 0xf, 0xf, false));
    x += __int_as_float(__builtin_amdgcn_update_dpp(0, __float_as_int(x), 0x4E, 0xf, 0xf, false));
    x += __int_as_float(__builtin_amdgcn_update_dpp(0, __float_as_int(x), 0x141, 0xf, 0xf, false));
    return x; }
template <int NJ> struct PrepSet { v4u c[NJ], p[NJ], n[NJ]; };
template <int J0, int NJ> __device__ __forceinline__ void prep_load(PrepSet<4>& S, const bf16* cur, const bf16* prv, const bf16* nxt, unsigned l16) {
#pragma unroll
    for (int jj = 0; jj < NJ; ++jj) { const unsigned off = l16 + 1024u * (J0 + jj); S.c[jj] = gld<v4u>(cur, off); S.p[jj] = gld<v4u>(prv, off); S.n[jj] = gld<v4u>(nxt, off); } }
template <int J> __device__ __forceinline__ void prep_shift(const PrepSet<4>& S, int jj, bool hp, bool hn, const LAS f32x4* mup, const LAS f32x4* mun, int lane, f32x4& r0, f32x4& r1) {
    f32x4 c0, c1, p0, p1, n0, n1; unpack8(S.c[jj], c0, c1); unpack8(S.p[jj], p0, p1); unpack8(S.n[jj], n0, n1);
    const f32x4 z = {0.f, 0.f, 0.f, 0.f}; if (!hp) { p0 = z; p1 = z; } if (!hn) { n0 = z; n1 = z; }
    const f32x4 a0 = mup[2 * lane + 128 * J], a1 = mup[2 * lane + 128 * J + 1], b0 = mun[2 * lane + 128 * J], b1 = mun[2 * lane + 128 * J + 1];
    r0 = c0 + a0 * (p0 - c0) + b0 * (n0 - c0); r1 = c1 + a1 * (p1 - c1) + b1 * (n1 - c1); }
template <int J0> __device__ __forceinline__ void prep_store4(const PrepSet<4>& S, bool hp, bool hn, const LAS f32x4* mup, const LAS f32x4* mun, bf16* dst, int lane) {
#pragma unroll
    for (int jj = 0; jj < 4; ++jj) { f32x4 r0, r1;
        switch (jj) { case 0: prep_shift<J0 + 0>(S, 0, hp, hn, mup, mun, lane, r0, r1); break; case 1: prep_shift<J0 + 1>(S, 1, hp, hn, mup, mun, lane, r0, r1); break;
                      case 2: prep_shift<J0 + 2>(S, 2, hp, hn, mup, mun, lane, r0, r1); break; default: prep_shift<J0 + 3>(S, 3, hp, hn, mup, mun, lane, r0, r1); break; }
        gst<v4u>(dst, (unsigned)lane * 16u + 1024u * jj, pack8(r0, r1)); __builtin_amdgcn_sched_barrier(0); } }
__device__ __forceinline__ void prep_store_k(const PrepSet<4>& S, bool hp, bool hn, const LAS f32x4* mup, const LAS f32x4* mun, const LAS f32x4* kk4, bf16* dstK, bf16* dstKK, int lane) {
#pragma unroll
    for (int jj = 0; jj < 4; ++jj) { f32x4 r0, r1;
        switch (jj) { case 0: prep_shift<4>(S, 0, hp, hn, mup, mun, lane, r0, r1); break; case 1: prep_shift<5>(S, 1, hp, hn, mup, mun, lane, r0, r1); break;
                      case 2: prep_shift<6>(S, 2, hp, hn, mup, mun, lane, r0, r1); break; default: prep_shift<7>(S, 3, hp, hn, mup, mun, lane, r0, r1); break; }
        gst<v4u>(dstK, (unsigned)lane * 16u + 1024u * jj, pack8(r0, r1));
        const f32x4 k0 = r0 * kk4[2 * lane + 128 * jj], k1 = r1 * kk4[2 * lane + 128 * jj + 1]; const float ss = sum8_lanes(dot4(k0, k0) + dot4(k1, k1));
        const float inv = 1.0f / fmaxf(sqrtf(ss), 1e-12f); gst<v4u>(dstKK, (unsigned)lane * 16u + 1024u * jj, pack8(k0 * inv, k1 * inv)); __builtin_amdgcn_sched_barrier(0); } }
__device__ __forceinline__ void prep_store_l(const PrepSet<4>& S, bool hp, bool hn, const LAS f32x4* mup, const LAS f32x4* mun, bf16* hw, bf16* xa, bf16* sg, int lane) {
    f32x4 r0, r1; prep_shift<12>(S, 0, hp, hn, mup, mun, lane, r0, r1);
    if (lane < 12) { const f32x4 t0 = {tanhf(r0.x), tanhf(r0.y), tanhf(r0.z), tanhf(r0.w)}, t1 = {tanhf(r1.x), tanhf(r1.y), tanhf(r1.z), tanhf(r1.w)}; gst<v4u>(hw, (unsigned)lane * 16u, pack8(t0, t1)); }
    else if (lane < 24) gst<v4u>(xa, (unsigned)(lane - 12) * 16u, pack8(r0, r1));
    else if (lane < 56) { const f32x4 t0 = {sigm(r0.x), sigm(r0.y), sigm(r0.z), sigm(r0.w)}, t1 = {sigm(r1.x), sigm(r1.y), sigm(r1.z), sigm(r1.w)}; gst<v4u>(sg, (unsigned)(lane - 24) * 16u, pack8(t0, t1)); }
    if (lane < 20) { const v4u z = {0u, 0u, 0u, 0u}; gst<v4u>(hw, 192u + (unsigned)lane * 16u, z); gst<v4u>(xa, 192u + (unsigned)lane * 16u, z); }
}
__device__ __forceinline__ void prep_phase(LAS unsigned char* ldsb, const PrepA& P, int gw, int NGW, int tid, int lane) {
    LAS f32x4* mup = (LAS f32x4*)ldsb; LAS f32x4* mun = mup + 1664; LAS f32x4* kk4 = mun + 1664;
    __syncthreads();
    for (int i = tid; i < RC / 4; i += NWAVES * 64) { mup[i] = ((const GAS f32x4*)P.mu_prev)[i]; mun[i] = ((const GAS f32x4*)P.mu_next)[i]; }
    for (int i = tid; i < DR / 4; i += NWAVES * 64) kk4[i] = ((const GAS f32x4*)P.k_k)[i];
    __syncthreads();
    const unsigned l16 = (unsigned)lane * 16u;
    int t = gw; if (t >= T) return;
    PrepSet<4> A, B;
#define PREP_ROWS(tt) const bf16* cur_ = P.PR + (size_t)(tt) * RCP; const bf16* prv_ = (tt) > 0 ? cur_ - RCP : cur_; const bf16* nxt_ = (tt) < T - 1 ? cur_ + RCP : cur_
    { PREP_ROWS(t); prep_load<0, 4>(A, cur_, prv_, nxt_, l16); }
#pragma unroll 1
    for (; t < T; t += NGW) {
        const bool hp = t > 0, hn = t < T - 1; const int tn = t + NGW < T ? t + NGW : t;
        PREP_ROWS(t);
        prep_load<4, 4>(B, cur_, prv_, nxt_, l16);  prep_store4<0>(A, hp, hn, mup, mun, P.R + (size_t)t * DR, lane);
        prep_load<8, 4>(A, cur_, prv_, nxt_, l16);  prep_store_k(B, hp, hn, mup, mun, kk4, P.K + (size_t)t * DR, P.KK + (size_t)t * DR, lane);
        prep_load<12, 1>(B, cur_, prv_, nxt_, l16); prep_store4<8>(A, hp, hn, mup, mun, P.V + (size_t)t * DR, lane);
        { const bf16* c2 = P.PR + (size_t)tn * RCP; const bf16* p2 = tn > 0 ? c2 - RCP : c2; const bf16* n2 = tn < T - 1 ? c2 + RCP : c2; prep_load<0, 4>(A, c2, p2, n2, l16); }
        prep_store_l(B, hp, hn, mup, mun, P.HW + (size_t)t * LK, P.XA + (size_t)t * LK, P.SG + (size_t)t * LK, lane);
    }
#undef PREP_ROWS
}

__device__ __forceinline__ void qk_norm_row(const bf16* qkvrow, float (&mx)[8], int lane) {
#pragma unroll
    for (int j = 0; j < 8; ++j) { const v4u w = *(const GAS v4u*)(qkvrow + 8 * lane + 512 * j); float ss = 0.f;
#pragma unroll
        for (int e = 0; e < 4; ++e) { const float lo = __uint_as_float(w[e] << 16), hi = __uint_as_float(w[e] & 0xffff0000u); ss += lo * lo + hi * hi; }
        ss += __shfl_xor(ss, 1); ss += __shfl_xor(ss, 2); ss += __shfl_xor(ss, 4);
        mx[j] = fmaxf(mx[j], ss); }
}

__device__ __forceinline__ void qk_load(v4u (&w)[8], const bf16* qkvrow, unsigned l16) {
#pragma unroll
    for (int j = 0; j < 8; ++j) w[j] = gld<v4u>(qkvrow, l16 + 1024u * j); }
__device__ __forceinline__ void qk_acc(const v4u (&w)[8], float (&mx)[8]) {
#pragma unroll
    for (int j = 0; j < 8; ++j) { float ss = 0.f;
#pragma unroll
        for (int e = 0; e < 4; ++e) { const float lo = __uint_as_float(w[j][e] << 16), hi = __uint_as_float(w[j][e] & 0xffff0000u); ss += lo * lo + hi * hi; }
        mx[j] = fmaxf(mx[j], sum8_lanes(ss)); } }
__device__ __forceinline__ void qk_norm_rows(const bf16* QKV, float (&mx)[8], int gw, int NGW, int lane) {
    const unsigned l16 = (unsigned)lane * 16u; int t = gw; if (t >= T) return;
    v4u a[8], b[8]; qk_load(a, QKV + (size_t)t * QKVW, l16);
#pragma unroll 1
    for (; t < T; t += 2 * NGW) { const int t1 = t + NGW < T ? t + NGW : t, t2 = t + 2 * NGW < T ? t + 2 * NGW : t;
        qk_load(b, QKV + (size_t)t1 * QKVW, l16); qk_acc(a, mx); qk_load(a, QKV + (size_t)t2 * QKVW, l16); qk_acc(b, mx); }
}

struct PostR { const float* YF; const float* YB; const bf16* V; const float* BF; const float* BB; const bf16* G; const float* gn_w; const float* gn_b; bf16* MIX; };
__device__ __forceinline__ void post_r_row(const PostR& P, int t, int lane) {
    const size_t ro = (size_t)t * DR;
#pragma unroll 2
    for (int j = 0; j < 8; ++j) {
        const int c0 = 4 * lane + 256 * j; const size_t o = ro + c0; const int hd = (lane >> 4) + 4 * j;
        const f32x4 y = *(const GAS f32x4*)(P.YF + o) + *(const GAS f32x4*)(P.YB + o);
        const float mean = row16_sum(sum4(y)) * (1.0f / 64.0f); const f32x4 d = y - mean;
        const float var = row16_sum(dot4(d, d)) * (1.0f / 64.0f); const float rs = 1.0f / sqrtf(var + GN_EPS);
        const f32x4 yn = d * rs * *(const GAS f32x4*)(P.gn_w + c0) + *(const GAS f32x4*)(P.gn_b + c0);
        const f32x4 v = bf4_to_f32(*(const GAS v2u*)(P.V + o)), g = bf4_to_f32(*(const GAS v2u*)(P.G + o));
        const float bs = ((const GAS float*)P.BF)[(size_t)t * NHR + hd] + ((const GAS float*)P.BB)[(size_t)t * NHR + hd];
        const f32x4 out = (yn + bs * v) * g;
        v2u w; w.x = pk2(out.x, out.y); w.y = pk2(out.z, out.w); *(GAS v2u*)(P.MIX + (size_t)t * D + c0) = w;
    }
}

namespace att {
typedef short s16x4 __attribute__((ext_vector_type(4)));
typedef float f32x16 __attribute__((ext_vector_type(16)));
constexpr int KVBLK = 64, LDK = QKVW;
constexpr int SHM_V = 16384, SHM_K = 8192, V_OFF = 0, K_OFF = 2 * SHM_V, WS_OFF = K_OFF + 2 * SHM_K;
constexpr float THR2 = 11.5f;
#define KSWZ64(row, colB) ((row) * 128 + ((colB) ^ ((((row) >> 1) & 7) << 4)))
#define SBAR() __builtin_amdgcn_sched_barrier(0)
__device__ __forceinline__ int crow(int r, int hi) { return (r & 3) + 8 * (r >> 2) + 4 * hi; }
__device__ __forceinline__ void partialSM(f32x16& p0, f32x16& p1, float& m_reg, float& mn, float& alpha, float tq, float nsl2) {
#ifndef ATT_NOBIAS
#pragma unroll
  for (int r = 0; r < 16; ++r) { const float d0 = tq + (float)((r & 3) + 8 * (r >> 2)); p0[r] = fmaf(fabsf(d0), nsl2, p0[r]); }
#pragma unroll
  for (int r = 0; r < 16; ++r) { const float d1 = tq + (float)(32 + (r & 3) + 8 * (r >> 2)); p1[r] = fmaf(fabsf(d1), nsl2, p1[r]); }
#endif
  float pmax = p0[0];
#pragma unroll
  for (int r = 1; r < 16; ++r) pmax = fmaxf(pmax, p0[r]);
#pragma unroll
  for (int r = 0; r < 16; ++r) pmax = fmaxf(pmax, p1[r]);
  { auto rr = __builtin_amdgcn_permlane32_swap(__float_as_uint(pmax), __float_as_uint(pmax), false, false);
    pmax = fmaxf(__uint_as_float(rr[0]), __uint_as_float(rr[1])); }
  if (__builtin_expect(__all(pmax - m_reg <= THR2), 1)) { mn = m_reg; alpha = 1.f; }
  else { mn = fmaxf(m_reg, pmax); alpha = __builtin_amdgcn_exp2f(m_reg - mn); m_reg = mn; }
#pragma unroll
  for (int r = 0; r < 16; ++r) p0[r] = __builtin_amdgcn_exp2f(p0[r] - mn);
#pragma unroll
  for (int r = 0; r < 16; ++r) p1[r] = p1[r] - mn;
}
__device__ __forceinline__ void finishSM(f32x16& p0, f32x16& p1, float alpha, float& l_reg, bf16x8& pa0, bf16x8& pa1, bf16x8& pa2, bf16x8& pa3) {
#pragma unroll
  for (int r = 0; r < 16; ++r) p1[r] = __builtin_amdgcn_exp2f(p1[r]);
  float ps = 0;
#pragma unroll
  for (int r = 0; r < 16; ++r) ps += p0[r];
#pragma unroll
  for (int r = 0; r < 16; ++r) ps += p1[r];
  { auto rr = __builtin_amdgcn_permlane32_swap(__float_as_uint(ps), __float_as_uint(ps), false, false);
    ps = __uint_as_float(rr[0]) + __uint_as_float(rr[1]); }
  l_reg = l_reg * alpha + ps;
#define PK4(P, BASE, OUT) do { unsigned a0 = pk2(P[BASE + 0], P[BASE + 1]), a1 = pk2(P[BASE + 2], P[BASE + 3]);   \
    unsigned b0 = pk2(P[BASE + 4], P[BASE + 5]), b1 = pk2(P[BASE + 6], P[BASE + 7]);                              \
    auto r0 = __builtin_amdgcn_permlane32_swap(a0, b0, false, false); auto r1 = __builtin_amdgcn_permlane32_swap(a1, b1, false, false); \
    v4u w = {r0[0], r1[0], r0[1], r1[1]}; OUT = *reinterpret_cast<bf16x8*>(&w); } while (0)
  PK4(p0, 0, pa0); PK4(p0, 8, pa1); PK4(p1, 0, pa2); PK4(p1, 8, pa3);
#undef PK4
}
__device__ __forceinline__ void qkt(f32x16& p0, f32x16& p1, const LAS unsigned char* Ks, const bf16x8* qr, int r32, int hi) {
  p0 = f32x16{}; p1 = f32x16{};
#pragma unroll
  for (int d0 = 0; d0 < 4; ++d0) { const int cb = d0 * 32 + hi * 16;
    const bf16x8 b0 = *reinterpret_cast<const LAS bf16x8*>(Ks + KSWZ64(r32, cb));
    const bf16x8 b1 = *reinterpret_cast<const LAS bf16x8*>(Ks + KSWZ64(32 + r32, cb));
    p0 = __builtin_amdgcn_mfma_f32_32x32x16_bf16(b0, qr[d0], p0, 0, 0, 0);
    p1 = __builtin_amdgcn_mfma_f32_32x32x16_bf16(b1, qr[d0], p1, 0, 0, 0); }
}
__device__ __forceinline__ int v_st(int k, int c) { const int kk = (k & ~0xC) | ((k & 4) << 1) | ((k & 8) >> 1); return ((kk >> 3) * 4 + (c >> 5)) * 512 + ((kk & 7) * 32 + (c & 31)) * 2; }
__device__ __forceinline__ int v_rd_base(int lane) { return ((lane & 3) << 3) | (((lane >> 2) & 3) << 6) | (((lane >> 4) & 1) << 5) | (((lane >> 5) & 1) << 8); }
constexpr int v_rd_off(int d0, int ks, int half) { return d0 * 512 + ks * 4096 + half * 2048; }
template <int OFF> __device__ __forceinline__ s16x4 tr_read(int vb) {
  s16x4 r; asm volatile("ds_read_b64_tr_b16 %0, %1 offset:%2" : "=&v"(r) : "v"(vb), "i"(OFF) : "memory"); return r;
}
template <int D0> __device__ __forceinline__ void pv_one(f32x16& od, int vb, bf16x8 pa0, bf16x8 pa1, bf16x8 pa2, bf16x8 pa3) {
  const s16x4 l0 = tr_read<v_rd_off(D0, 0, 0)>(vb), h0 = tr_read<v_rd_off(D0, 0, 1)>(vb), l1 = tr_read<v_rd_off(D0, 1, 0)>(vb), h1 = tr_read<v_rd_off(D0, 1, 1)>(vb);
  const s16x4 l2 = tr_read<v_rd_off(D0, 2, 0)>(vb), h2 = tr_read<v_rd_off(D0, 2, 1)>(vb), l3 = tr_read<v_rd_off(D0, 3, 0)>(vb), h3 = tr_read<v_rd_off(D0, 3, 1)>(vb);
  asm volatile("s_waitcnt lgkmcnt(0)" ::: "memory"); SBAR();
#define PKV(L, H) (bf16x8){L[0], L[1], L[2], L[3], H[0], H[1], H[2], H[3]}
  od = __builtin_amdgcn_mfma_f32_32x32x16_bf16(pa0, PKV(l0, h0), od, 0, 0, 0);
  od = __builtin_amdgcn_mfma_f32_32x32x16_bf16(pa1, PKV(l1, h1), od, 0, 0, 0);
  od = __builtin_amdgcn_mfma_f32_32x32x16_bf16(pa2, PKV(l2, h2), od, 0, 0, 0);
  od = __builtin_amdgcn_mfma_f32_32x32x16_bf16(pa3, PKV(l3, h3), od, 0, 0, 0);
#undef PKV
}
#define PKV(L, H) (bf16x8){L[0], L[1], L[2], L[3], H[0], H[1], H[2], H[3]}
template <int D0> __device__ __forceinline__ void pv_rd(s16x4 (&v)[8], int vb) {
  v[0] = tr_read<v_rd_off(D0, 0, 0)>(vb); v[1] = tr_read<v_rd_off(D0, 0, 1)>(vb); v[2] = tr_read<v_rd_off(D0, 1, 0)>(vb); v[3] = tr_read<v_rd_off(D0, 1, 1)>(vb);
  v[4] = tr_read<v_rd_off(D0, 2, 0)>(vb); v[5] = tr_read<v_rd_off(D0, 2, 1)>(vb); v[6] = tr_read<v_rd_off(D0, 3, 0)>(vb); v[7] = tr_read<v_rd_off(D0, 3, 1)>(vb);
}
__device__ __forceinline__ void pv_mm(f32x16& od, const s16x4 (&v)[8], bf16x8 pa0, bf16x8 pa1, bf16x8 pa2, bf16x8 pa3) {
  od = __builtin_amdgcn_mfma_f32_32x32x16_bf16(pa0, PKV(v[0], v[1]), od, 0, 0, 0);
  od = __builtin_amdgcn_mfma_f32_32x32x16_bf16(pa1, PKV(v[2], v[3]), od, 0, 0, 0);
  od = __builtin_amdgcn_mfma_f32_32x32x16_bf16(pa2, PKV(v[4], v[5]), od, 0, 0, 0);
  od = __builtin_amdgcn_mfma_f32_32x32x16_bf16(pa3, PKV(v[6], v[7]), od, 0, 0, 0);
}
__device__ __forceinline__ void pv_d0(f32x16* o, int vb, bf16x8 pa0, bf16x8 pa1, bf16x8 pa2, bf16x8 pa3) {
  s16x4 va[8], vb_[8];
  pv_rd<0>(va, vb); pv_rd<1>(vb_, vb);
  asm volatile("s_waitcnt lgkmcnt(8)" ::: "memory"); SBAR(); pv_mm(o[0], va, pa0, pa1, pa2, pa3); SBAR();
  pv_rd<2>(va, vb);
  asm volatile("s_waitcnt lgkmcnt(8)" ::: "memory"); SBAR(); pv_mm(o[1], vb_, pa0, pa1, pa2, pa3); SBAR();
  pv_rd<3>(vb_, vb);
  asm volatile("s_waitcnt lgkmcnt(8)" ::: "memory"); SBAR(); pv_mm(o[2], va, pa0, pa1, pa2, pa3); SBAR();
  asm volatile("s_waitcnt lgkmcnt(0)" ::: "memory"); SBAR(); pv_mm(o[3], vb_, pa0, pa1, pa2, pa3);
}
#undef PKV

template <int c> __device__ __forceinline__ void map_epilogue(f32x16 (&o)[4], float l_reg, LAS float* li_l, float* stash, bf16* __restrict__ MIX, const float* __restrict__ subln_g, float lam,
                                                              int h, int i0, int tid, int wid, int r32, int hi) {
    if (hi == 0) li_l[r32] = l_reg; asm volatile("s_waitcnt lgkmcnt(0)" ::: "memory");
    float rli[16];
#pragma unroll
    for (int r = 0; r < 16; ++r) rli[r] = __builtin_amdgcn_rcpf(li_l[crow(r, hi)]);
    if (c == 0) {
#pragma unroll
      for (int d0 = 0; d0 < 4; ++d0)
#pragma unroll
        for (int r = 0; r < 16; ++r) ((GAS float*)stash)[(size_t)(d0 * 16 + r) * 512 + tid] = o[d0][r] * rli[r];
    } else {
#ifndef ATT_NOEPI
      float ssq[16];
#pragma unroll
      for (int r = 0; r < 16; ++r) { float s = 0.f;
#pragma unroll
        for (int d0 = 0; d0 < 4; ++d0) { const float v = __hip_atomic_load((GAS float*)stash + (size_t)(d0 * 16 + r) * 512 + tid, __ATOMIC_RELAXED, __HIP_MEMORY_SCOPE_AGENT) - lam * (o[d0][r] * rli[r]); o[d0][r] = v; s += v * v; }
        ssq[r] = s; }
#pragma unroll
      for (int r = 0; r < 16; ++r) {
#pragma unroll
        for (int x = 1; x < 32; x <<= 1) ssq[r] += __shfl_xor(ssq[r], x); }
      float sg[4];
#pragma unroll
      for (int d0 = 0; d0 < 4; ++d0) sg[d0] = ((const GAS float*)subln_g)[32 * d0 + r32] * (1.0f - LAM_INIT);
#pragma unroll
      for (int r = 0; r < 16; ++r) { const float rs = 1.0f / sqrtf(ssq[r] * (1.0f / 128.0f) + SUBLN_EPS);
        GAS bf16* orow = (GAS bf16*)MIX + (size_t)(i0 + wid * 32 + crow(r, hi)) * D + 2048 + h * 128 + r32;
#pragma unroll
        for (int d0 = 0; d0 < 4; ++d0) orow[32 * d0] = (bf16)(pk2(o[d0][r] * rs * sg[d0], 0.f) & 0xffffu); }
#endif
    }
}

template <int c> __device__ __forceinline__ void attn_map(LAS unsigned char* lds, const bf16* __restrict__ QKV, float* stash, bf16* __restrict__ MIX, const float* __restrict__ subln_g,
                                          int h, int i0, float lam, float sl2, int W) {
  int tid_ = threadIdx.x; asm volatile("" : "+v"(tid_));
  asm volatile("" : "+s"(QKV), "+s"(stash), "+s"(MIX), "+s"(subln_g), "+s"(h), "+s"(i0), "+s"(W));
  const int tid = tid_, wid = tid >> 6, lane = tid & 63, r32 = lane & 31, hi = lane >> 5;
  LAS unsigned char* V_lds = lds + V_OFF; LAS unsigned char* K_lds = lds + K_OFF;
  LAS float* ws = (LAS float*)(lds + WS_OFF) + wid * 64; LAS float* li_l = ws; LAS float* al_l = ws + 32;
  const int sr = tid >> 4, sc = (tid & 15) * 8, vst0 = v_st(sr, sc), vst1 = v_st(32 + sr, sc);
  const int kr = tid >> 3, kc = (tid & 7) * 8, kst = KSWZ64(kr, kc * 2);
  const int vb0 = (int)(unsigned)(uintptr_t)V_lds + v_rd_base(lane);
  const int qi = i0 + wid * 32 + r32; const float nsl2 = -sl2;
  int jlo = (i0 - W > 0 ? i0 - W : 0) >> 6, jhi = (i0 + 255 + W < T - 1 ? i0 + 255 + W : T - 1) >> 6;
  if (((jhi - jlo + 1) & 1) != 0) { if (jhi < T / KVBLK - 1) ++jhi; else --jlo; }
  const int NT = jhi - jlo + 1;
  {
    const bf16* Kh = QKV + 2048 + h * 128 + c * 64; const bf16* Vh = QKV + 4096 + h * 128;
    float m_reg = -1e30f, l_reg = 0; f32x16 o[4] = {}; bf16x8 qr[4];
    { const bf16* Qw = QKV + (size_t)qi * LDK + h * 128 + c * 64 + hi * 8;
#pragma unroll
      for (int d0 = 0; d0 < 4; ++d0) qr[d0] = *(const GAS bf16x8*)(Qw + d0 * 16); }
    struct { bf16x8 vs0, vs1, ks0; } sr_[2];
#define SLOAD(i, k0) do { sr_[i].vs0 = *(const GAS bf16x8*)(&Vh[(size_t)((k0) + sr) * LDK + sc]); sr_[i].vs1 = *(const GAS bf16x8*)(&Vh[(size_t)((k0) + 32 + sr) * LDK + sc]); \
    sr_[i].ks0 = *(const GAS bf16x8*)(&Kh[(size_t)((k0) + kr) * LDK + kc]); } while (0)
#define SWRITE(b, i) do { *(LAS bf16x8*)(V_lds + (b) * SHM_V + vst0) = sr_[i].vs0; *(LAS bf16x8*)(V_lds + (b) * SHM_V + vst1) = sr_[i].vs1; \
    *(LAS bf16x8*)(K_lds + (b) * SHM_K + kst) = sr_[i].ks0; } while (0)
#define SWAIT() asm volatile("s_waitcnt vmcnt(3)" ::: "memory")
#define RESC(a) do { if (__any((a) < 1.f)) { if (hi == 0) al_l[r32] = (a); asm volatile("s_waitcnt lgkmcnt(0)" ::: "memory"); \
    _Pragma("unroll") for (int d = 0; d < 4; ++d) _Pragma("unroll") for (int r = 0; r < 16; ++r) o[d][r] *= al_l[crow(r, hi)]; } } while (0)
#define TQ(tile) ((float)((jlo + (tile)) * KVBLK + 4 * hi - qi))
#define KOFF(tile) ((jlo + (tile)) * KVBLK)
    f32x16 pA0, pA1, pB0, pB1; float mnA, mnB, alA, alB; bf16x8 pa0, pa1, pa2, pa3;
    __syncthreads();
    SLOAD(0, KOFF(0)); asm volatile("s_waitcnt vmcnt(0)" ::: "memory"); SWRITE(0, 0); __syncthreads();
    qkt(pA0, pA1, K_lds, qr, r32, hi); partialSM(pA0, pA1, m_reg, mnA, alA, TQ(0), nsl2);
    SLOAD(1, KOFF(1)); SLOAD(0, KOFF(2));
    SWAIT(); SWRITE(1, 1); __syncthreads();
#pragma unroll 1
    for (int j = 1; j + 1 < NT; j += 2) {
      SBAR(); qkt(pB0, pB1, K_lds + SHM_K, qr, r32, hi);
      finishSM(pA0, pA1, alA, l_reg, pa0, pa1, pa2, pa3); SBAR();
      SLOAD(1, KOFF(j + 2)); SBAR();
      pv_d0(o, vb0, pa0, pa1, pa2, pa3); partialSM(pB0, pB1, m_reg, mnB, alB, TQ(j), nsl2);
      __syncthreads(); SWAIT(); SWRITE(0, 0);
      RESC(alB); __syncthreads();
      SBAR(); qkt(pA0, pA1, K_lds, qr, r32, hi);
      finishSM(pB0, pB1, alB, l_reg, pa0, pa1, pa2, pa3); SBAR();
      if (j + 3 < NT) SLOAD(0, KOFF(j + 3)); SBAR();
      pv_d0(o, vb0 + SHM_V, pa0, pa1, pa2, pa3); partialSM(pA0, pA1, m_reg, mnA, alA, TQ(j + 1), nsl2);
      __syncthreads(); SWAIT(); SWRITE(1, 1);
      RESC(alA); __syncthreads();
    }
    SBAR(); qkt(pB0, pB1, K_lds + SHM_K, qr, r32, hi);
    finishSM(pA0, pA1, alA, l_reg, pa0, pa1, pa2, pa3); SBAR();
    pv_d0(o, vb0, pa0, pa1, pa2, pa3); partialSM(pB0, pB1, m_reg, mnB, alB, TQ(NT - 1), nsl2);
    __syncthreads(); RESC(alB);
    finishSM(pB0, pB1, alB, l_reg, pa0, pa1, pa2, pa3); SBAR();
    pv_d0(o, vb0 + SHM_V, pa0, pa1, pa2, pa3);
    map_epilogue<c>(o, l_reg, li_l, stash, MIX, subln_g, lam, h, i0, tid, wid, r32, hi);
#undef SLOAD
#undef SWRITE
#undef SWAIT
#undef RESC
#undef TQ
#undef KOFF
  }
}
__device__ __forceinline__ unsigned bfbits(float x) { return pk2(x, 0.f) & 0xffffu; }
__device__ __forceinline__ void qkt_fast(f32x16& p0, f32x16& p1, const LAS unsigned char* Ks, const bf16x8* qr, int r32, int hi, bool aug, v4u ka0, v4u ka1, v4u qa) {
  p0 = f32x16{}; p1 = f32x16{};
#pragma unroll
  for (int d0 = 0; d0 < 4; ++d0) { const int cb = d0 * 32 + hi * 16;
    const bf16x8 b0 = *reinterpret_cast<const LAS bf16x8*>(Ks + KSWZ64(r32, cb));
    const bf16x8 b1 = *reinterpret_cast<const LAS bf16x8*>(Ks + KSWZ64(32 + r32, cb));
    p0 = __builtin_amdgcn_mfma_f32_32x32x16_bf16(b0, qr[d0], p0, 0, 0, 0);
    p1 = __builtin_amdgcn_mfma_f32_32x32x16_bf16(b1, qr[d0], p1, 0, 0, 0); }
  if (aug) {
    p0 = __builtin_amdgcn_mfma_f32_32x32x16_bf16(*reinterpret_cast<bf16x8*>(&ka0), *reinterpret_cast<bf16x8*>(&qa), p0, 0, 0, 0);
    p1 = __builtin_amdgcn_mfma_f32_32x32x16_bf16(*reinterpret_cast<bf16x8*>(&ka1), *reinterpret_cast<bf16x8*>(&qa), p1, 0, 0, 0); }
}
__device__ __forceinline__ void partialSM_fast(f32x16& p0, f32x16& p1, bool mixed, float tq, float nsl2, float nBref) {
  if (mixed) {
#pragma unroll
    for (int r = 0; r < 16; ++r) { const float d0 = tq + (float)((r & 3) + 8 * (r >> 2)); p0[r] = fmaf(fabsf(d0), nsl2, p0[r] + nBref); }
#pragma unroll
    for (int r = 0; r < 16; ++r) { const float d1 = tq + (float)(32 + (r & 3) + 8 * (r >> 2)); p1[r] = fmaf(fabsf(d1), nsl2, p1[r] + nBref); }
  }
#pragma unroll
  for (int r = 0; r < 16; ++r) p0[r] = __builtin_amdgcn_exp2f(p0[r]);
}
__device__ __forceinline__ void finishSM_fast(f32x16& p0, f32x16& p1, float& l_reg, bf16x8& pa0, bf16x8& pa1, bf16x8& pa2, bf16x8& pa3) {
#pragma unroll
  for (int r = 0; r < 16; ++r) p1[r] = __builtin_amdgcn_exp2f(p1[r]);
  float ps = 0;
#pragma unroll
  for (int r = 0; r < 16; ++r) ps += p0[r];
#pragma unroll
  for (int r = 0; r < 16; ++r) ps += p1[r];
  { auto rr = __builtin_amdgcn_permlane32_swap(__float_as_uint(ps), __float_as_uint(ps), false, false);
    ps = __uint_as_float(rr[0]) + __uint_as_float(rr[1]); }
  l_reg += ps;
#define PK4(P, BASE, OUT) do { unsigned a0 = pk2(P[BASE + 0], P[BASE + 1]), a1 = pk2(P[BASE + 2], P[BASE + 3]);   \
    unsigned b0 = pk2(P[BASE + 4], P[BASE + 5]), b1 = pk2(P[BASE + 6], P[BASE + 7]);                              \
    auto r0 = __builtin_amdgcn_permlane32_swap(a0, b0, false, false); auto r1 = __builtin_amdgcn_permlane32_swap(a1, b1, false, false); \
    v4u w = {r0[0], r1[0], r0[1], r1[1]}; OUT = *reinterpret_cast<bf16x8*>(&w); } while (0)
  PK4(p0, 0, pa0); PK4(p0, 8, pa1); PK4(p1, 0, pa2); PK4(p1, 8, pa3);
#undef PK4
}
constexpr int RING_SLOT = SHM_V + SHM_K, RING_NB = 4, FAST_WS_OFF = RING_NB * RING_SLOT;
template <int OFF> __device__ __forceinline__ bf16x8 lds_rd128(int addr) { bf16x8 r; asm volatile("ds_read_b128 %0, %1 offset:%2" : "=&v"(r) : "v"(addr), "i"(OFF) : "memory"); return r; }
template <int SLOT> __device__ __forceinline__ void qkt_ring2(f32x16& p0, f32x16& p1, const int (&kad)[4], const bf16x8* qr, bool aug, v4u ka0, v4u ka1, v4u qa) {
  constexpr int KB = SLOT * RING_SLOT + SHM_V;
  const int k0a = kad[0] + KB, k1a = kad[1] + KB, k2a = kad[2] + KB, k3a = kad[3] + KB;
  const bf16x8 a0 = lds_rd128<0>(k0a), b0 = lds_rd128<32 * 128>(k0a), a1 = lds_rd128<0>(k1a), b1 = lds_rd128<32 * 128>(k1a);
  const bf16x8 a2 = lds_rd128<0>(k2a), b2 = lds_rd128<32 * 128>(k2a), a3 = lds_rd128<0>(k3a), b3 = lds_rd128<32 * 128>(k3a);
  p0 = f32x16{}; p1 = f32x16{};
  asm volatile("s_waitcnt lgkmcnt(0)" ::: "memory"); SBAR();
  p0 = __builtin_amdgcn_mfma_f32_32x32x16_bf16(a0, qr[0], p0, 0, 0, 0); p1 = __builtin_amdgcn_mfma_f32_32x32x16_bf16(b0, qr[0], p1, 0, 0, 0);
  p0 = __builtin_amdgcn_mfma_f32_32x32x16_bf16(a1, qr[1], p0, 0, 0, 0); p1 = __builtin_amdgcn_mfma_f32_32x32x16_bf16(b1, qr[1], p1, 0, 0, 0);
  p0 = __builtin_amdgcn_mfma_f32_32x32x16_bf16(a2, qr[2], p0, 0, 0, 0); p1 = __builtin_amdgcn_mfma_f32_32x32x16_bf16(b2, qr[2], p1, 0, 0, 0);
  p0 = __builtin_amdgcn_mfma_f32_32x32x16_bf16(a3, qr[3], p0, 0, 0, 0); p1 = __builtin_amdgcn_mfma_f32_32x32x16_bf16(b3, qr[3], p1, 0, 0, 0);
  if (aug) {
    p0 = __builtin_amdgcn_mfma_f32_32x32x16_bf16(*reinterpret_cast<bf16x8*>(&ka0), *reinterpret_cast<bf16x8*>(&qa), p0, 0, 0, 0);
    p1 = __builtin_amdgcn_mfma_f32_32x32x16_bf16(*reinterpret_cast<bf16x8*>(&ka1), *reinterpret_cast<bf16x8*>(&qa), p1, 0, 0, 0); }
}
template <int c, int VAR> __device__ __forceinline__ void attn_map_fast(LAS unsigned char* lds, const bf16* __restrict__ QKV, float* stash, bf16* __restrict__ MIX, const float* __restrict__ subln_g,
                                               int h, int i0, float lam, float sl2, int W, float Bref) {
  int tid_ = threadIdx.x; asm volatile("" : "+v"(tid_));
  asm volatile("" : "+s"(QKV), "+s"(stash), "+s"(MIX), "+s"(subln_g), "+s"(h), "+s"(i0), "+s"(W));
  const int tid = tid_, wid = tid >> 6, lane = tid & 63, r32 = lane & 31, hi = lane >> 5;
  const int wave_u = __builtin_amdgcn_readfirstlane(wid);
  LAS float* li_l = (LAS float*)(lds + FAST_WS_OFF) + wid * 64;
  const int lds0 = (int)(unsigned)(uintptr_t)lds;
  const int vb0 = lds0 + v_rd_base(lane);
  int kad[4];
#pragma unroll
  for (int d0 = 0; d0 < 4; ++d0) kad[d0] = lds0 + KSWZ64(r32, d0 * 32 + hi * 16);
  int goK, goV0, goV1;
  { const int row = tid >> 3, lc = (tid & 7) ^ ((row >> 1) & 7); goK = row * LDK + lc * 8; }
#define VSRC(L, OUT) do { const int sub_ = (L) >> 5, rem_ = (L) & 31, kk_ = ((sub_ >> 2) << 3) | (rem_ >> 2), cc_ = ((sub_ & 3) << 5) | ((rem_ & 3) << 3); \
    const int k_ = (kk_ & ~0xC) | ((kk_ & 4) << 1) | ((kk_ & 8) >> 1); OUT = k_ * LDK + cc_; } while (0)
  VSRC(tid, goV0); VSRC(512 + tid, goV1);
#undef VSRC
  const int iw = i0 + wave_u * 32, qi = iw + r32; const float nsl2 = -sl2, nBref = -Bref;
  int jlo = (i0 - W > 0 ? i0 - W : 0) >> 6, jhi = (i0 + 255 + W < T - 1 ? i0 + 255 + W : T - 1) >> 6;
  while (((jhi - jlo + 1) & 3) != 0) { if (jhi < T / KVBLK - 1) ++jhi; else --jlo; }
  const int NT = jhi - jlo + 1;
  const float s1f = __uint_as_float(bfbits(sl2) << 16), s2f = __uint_as_float(bfbits(sl2 - s1f) << 16), s3f = __uint_as_float(bfbits(sl2 - s1f - s2f) << 16);
  const unsigned S1 = bfbits(s1f), S2 = bfbits(s2f), S3 = bfbits(s3f), II = bfbits((float)r32), J0 = bfbits((float)r32), J1 = bfbits((float)(32 + r32)), ONE = 0x3f80u, NEG = 0x8000u;
  v4u qa = hi ? (v4u){0u, 0u, 0u, 0u} : (v4u){S1 | (S2 << 16), S3 | (II << 16), II | (II << 16), 0u};
  v4u ka0 = hi ? (v4u){ONE, 0u, 0u, 0u} : (v4u){J0 | (J0 << 16), J0 | ((S1 ^ NEG) << 16), (S2 ^ NEG) | ((S3 ^ NEG) << 16), ONE | (ONE << 16)};
  v4u ka1 = hi ? (v4u){ONE, 0u, 0u, 0u} : (v4u){J1 | (J1 << 16), J1 | ((S1 ^ NEG) << 16), (S2 ^ NEG) | ((S3 ^ NEG) << 16), ONE | (ONE << 16)};
  const unsigned flipm = hi ? 0u : 0x80008000u;
  bool right_signs = false;
#define TILE_SETUP(tile, MIXED) do { const int k0_ = (jlo + (tile)) * KVBLK; const bool left_ = k0_ + 63 <= iw, right_ = k0_ >= iw + 31; MIXED = !(left_ || right_); \
    if (right_ && !right_signs) { right_signs = true; ka0.x ^= flipm; ka0.y ^= flipm; ka0.z ^= flipm; ka1.x ^= flipm; ka1.y ^= flipm; ka1.z ^= flipm; } \
    const int dd_ = iw - k0_; const float c_ = nsl2 * (float)(dd_ < 0 ? -dd_ : dd_) + nBref; \
    const unsigned w1_ = bfbits(c_); const float r1_ = c_ - __uint_as_float(w1_ << 16); const unsigned w2_ = bfbits(r1_); const float r2_ = r1_ - __uint_as_float(w2_ << 16); const unsigned w3_ = bfbits(r2_); \
    if (hi) qa.x = w3_; else qa.w = w1_ | (w2_ << 16); } while (0)
  {
    const bf16* Kh = QKV + 2048 + h * 128 + c * 64; const bf16* Vh = QKV + 4096 + h * 128;
    float l_reg = 0; f32x16 o[4] = {}; bf16x8 qr[4];
    { const bf16* Qw = QKV + (size_t)qi * LDK + h * 128 + c * 64 + hi * 8;
#pragma unroll
      for (int d0 = 0; d0 < 4; ++d0) qr[d0] = *(const GAS bf16x8*)(Qw + d0 * 16); }
#define DMA(tile, SLOT) do { if (VAR & 8) break; const int tt_ = (tile) < NT ? (tile) : NT - 1; const size_t kb_ = (size_t)((jlo + tt_) * KVBLK) * LDK; \
    __builtin_amdgcn_global_load_lds((const unsigned*)(Vh + kb_ + goV0), (LAS unsigned*)(lds + (SLOT) * RING_SLOT + wave_u * 1024), 16, 0, 0); \
    __builtin_amdgcn_global_load_lds((const unsigned*)(Vh + kb_ + goV1), (LAS unsigned*)(lds + (SLOT) * RING_SLOT + 8192 + wave_u * 1024), 16, 0, 0); \
    __builtin_amdgcn_global_load_lds((const unsigned*)(Kh + kb_ + goK), (LAS unsigned*)(lds + (SLOT) * RING_SLOT + SHM_V + wave_u * 1024), 16, 0, 0); } while (0)
#define RBAR() do { if (VAR & 16) break; asm volatile("s_waitcnt vmcnt(3)" ::: "memory"); __builtin_amdgcn_s_barrier(); asm volatile("" ::: "memory"); } while (0)
#define TQ(tile) ((float)((jlo + (tile)) * KVBLK + 4 * hi - qi))
    f32x16 pA0 = {}, pA1 = {}, pB0 = {}, pB1 = {}; bf16x8 pa0 = {}, pa1 = {}, pa2 = {}, pa3 = {}; bool mx; const bool lead = wave_u < 4;
    asm volatile("s_waitcnt vmcnt(0)" ::: "memory");
    __syncthreads();
    DMA(0, 0); DMA(1, 1); DMA(2, 2);
    asm volatile("s_waitcnt vmcnt(6)" ::: "memory"); __builtin_amdgcn_s_barrier(); asm volatile("" ::: "memory");
#define TSTEP_A(tt, SLOT, PREV, PC0, PC1, PP0, PP1, HASPREV) do { \
        TILE_SETUP(tt, mx); \
        if (!(VAR & 4)) qkt_ring2<SLOT>(PC0, PC1, kad, qr, !mx, ka0, ka1, qa); \
        if (HASPREV) { if (!(VAR & 2)) finishSM_fast(PP0, PP1, l_reg, pa0, pa1, pa2, pa3); SBAR(); if (!(VAR & 1)) pv_d0(o, vb0 + (PREV) * RING_SLOT, pa0, pa1, pa2, pa3); } \
        if (!(VAR & 2)) partialSM_fast(PC0, PC1, mx, TQ(tt), nsl2, nBref); } while (0)
#define TSTEP_B(tt, SLOT, PREV, PC0, PC1, PP0, PP1, HASPREV) do { \
        TILE_SETUP(tt, mx); \
        if (HASPREV) { if (!(VAR & 2)) finishSM_fast(PP0, PP1, l_reg, pa0, pa1, pa2, pa3); SBAR(); } \
        if (!(VAR & 4)) qkt_ring2<SLOT>(PC0, PC1, kad, qr, !mx, ka0, ka1, qa); \
        if (!(VAR & 2)) partialSM_fast(PC0, PC1, mx, TQ(tt), nsl2, nBref); SBAR(); \
        if (HASPREV) { if (!(VAR & 1)) pv_d0(o, vb0 + (PREV) * RING_SLOT, pa0, pa1, pa2, pa3); } } while (0)
#define TLOOP(TS) _Pragma("unroll 1") for (int t = 0; t < NT; t += 4) { \
      TS(t, 0, 3, pA0, pA1, pB0, pB1, t > 0);      RBAR(); DMA(t + 3, 3); \
      TS(t + 1, 1, 0, pB0, pB1, pA0, pA1, true);   RBAR(); DMA(t + 4, 0); \
      TS(t + 2, 2, 1, pA0, pA1, pB0, pB1, true);   RBAR(); DMA(t + 5, 1); \
      TS(t + 3, 3, 2, pB0, pB1, pA0, pA1, true);   RBAR(); DMA(t + 6, 2); }
    if (lead) { TLOOP(TSTEP_A) } else { TLOOP(TSTEP_B) }
#undef TSTEP_A
#undef TSTEP_B
#undef TLOOP
    finishSM_fast(pB0, pB1, l_reg, pa0, pa1, pa2, pa3); SBAR(); pv_d0(o, vb0 + 3 * RING_SLOT, pa0, pa1, pa2, pa3);
    asm volatile("s_waitcnt vmcnt(0)" ::: "memory");
    map_epilogue<c>(o, l_reg, li_l, stash, MIX, subln_g, lam, h, i0, tid, wid, r32, hi);
#undef DMA
#undef RBAR
#undef TQ
#undef TILE_SETUP
  }
}
template <int VAR> __device__ __forceinline__ void attn_unit(LAS unsigned char* lds, const bf16* __restrict__ QKV, float* stash, bf16* __restrict__ MIX, const float* __restrict__ subln_g,
                                          int h, int i0, float lam, float sl2, float qn2a, float kn2a, float qn2b, float kn2b) {
  const float Ba = sqrtf(qn2a * kn2a) * 1.0001f + 0.01f, Bb = sqrtf(qn2b * kn2b) * 1.0001f + 0.01f;
  const bool fa = __builtin_amdgcn_readfirstlane((int)(2.0f * Ba < 100.0f)) != 0, fb = __builtin_amdgcn_readfirstlane((int)(2.0f * Bb < 100.0f)) != 0;
  const float wa = (fa ? 134.0f : 2.0f * Ba + THR2 + 134.0f) / sl2, wb = (fb ? 134.0f : 2.0f * Bb + THR2 + 134.0f) / sl2;
  const int W0 = __builtin_amdgcn_readfirstlane(wa < 16384.0f ? (int)wa + 1 : 16384), W1 = __builtin_amdgcn_readfirstlane(wb < 16384.0f ? (int)wb + 1 : 16384);
  if (fa) attn_map_fast<0, VAR>(lds, QKV, stash, MIX, subln_g, h, i0, lam, sl2, W0, Ba); else attn_map<0>(lds, QKV, stash, MIX, subln_g, h, i0, lam, sl2, W0);
  if (fb) attn_map_fast<1, VAR>(lds, QKV, stash, MIX, subln_g, h, i0, lam, sl2, W1, Bb); else attn_map<1>(lds, QKV, stash, MIX, subln_g, h, i0, lam, sl2, W1);
}
}

namespace scan {
constexpr int CH = 16, NCH = T / CH;
constexpr int VEC_OFF = 0, VEC_BYTES = CH * 5 * 64 * 4;
constexpr int VV_OFF = 2 * VEC_BYTES, VV_BYTES = CH * 32 * 4;
constexpr int YP_OFF = VV_OFF + 2 * VV_BYTES, YP_BYTES = CH * 512 * 4;
constexpr int SCAN_LDS = YP_OFF + 2 * YP_BYTES;
struct ConvJob { const float* wg; const float* wu; const float* wd; bf16* WGU2; bf16* WD2; int wave_gid, n_waves; };
constexpr int CV_GATE = (D / 64) * (FF / 32), CV_DOWN = (FF / 64) * (D / 32), CV_ITEMS = 2 * CV_GATE + CV_DOWN;
constexpr int CV_SCR_OFF = 110592, CV_SCR_BYTES = 64 * 33 * 4;
static_assert(TAIL_GU <= CV_GATE && TAIL_WD2 < CV_DOWN, "tail splits");
struct Tensors { const bf16* R; const bf16* K; const bf16* KK; const bf16* V; const float* DEC[2]; const float* A[2]; const float* k_a; float* Y[2]; const float* r_k; float* BON[2]; };

template <int var> __device__ __forceinline__ void scan_unit(LAS unsigned char* lds, const Tensors& P, const ConvJob& CJ, int h, int dir, int rg, float* dummy) {
    int tid_ = threadIdx.x; asm volatile("" : "+v"(tid_));
    const int tid = tid_, wave = __builtin_amdgcn_readfirstlane(tid >> 6), lane = tid & 63;
    const float* DEC = dir ? P.DEC[1] : P.DEC[0]; const float* AA = dir ? P.A[1] : P.A[0]; float* Y = dir ? P.Y[1] : P.Y[0]; float* BON = dir ? P.BON[1] : P.BON[0]; if (var & 1) { Y = dummy; BON = dummy; }
    const int chan0 = h * 64, row0 = chan0 + 32 * rg;
    const int hw = wave - 4;
#define DECLSET(n) v2u k##n, kk##n, r##n, v##n; f32x4 w##n, a##n
    DECLSET(0); DECLSET(1); DECLSET(2); DECLSET(3);
    const int hi_ = lane >> 4, hq = lane & 15;
    f32x4 kav = *(const GAS f32x4*)(P.k_a + chan0 + 4 * hq), rkv = *(const GAS f32x4*)(P.r_k + chan0 + 4 * hq);
    asm volatile("" : "+v"(kav), "+v"(rkv));
#define TSTEP(step) (dir ? (T - 1 - (step)) : (step))
#define HLOAD(n, chunk) do { const int t_ = TSTEP((chunk) * CH + hw * 4 + hi_); const size_t ix = (size_t)t_ * DR + chan0 + 4 * hq; \
        k##n = *(const GAS v2u*)(P.K + ix); kk##n = *(const GAS v2u*)(P.KK + ix); r##n = *(const GAS v2u*)(P.R + ix); w##n = *(const GAS f32x4*)(DEC + ix); a##n = *(const GAS f32x4*)(AA + ix); \
        v##n = *(const GAS v2u*)(P.V + (size_t)t_ * DR + row0 + 4 * (hq & 7)); } while (0)
#define HSTAGE(n, buf, chunk) do { LAS f32x4* vp = (LAS f32x4*)(lds + VEC_OFF + (buf) * VEC_BYTES) + (hw * 4 + hi_) * 80 + hq; const f32x4 kkf_ = bf4_to_f32(kk##n); \
        const f32x4 kd_ = bf4_to_f32(k##n) * (1.0f + (a##n - 1.0f) * kav), rf_ = bf4_to_f32(r##n); \
        vp[0] = -kkf_; vp[16] = w##n; vp[32] = kkf_ * a##n; vp[48] = kd_; vp[64] = rf_; \
        if (hq < 8) ((LAS f32x4*)(lds + VV_OFF + (buf) * VV_BYTES))[(hw * 4 + hi_) * 8 + hq] = bf4_to_f32(v##n); \
          \
        const float bs_ = row16_sum(dot4(rf_ * kd_, rkv)); \
        if (hq == 0) BON[(size_t)TSTEP(((chunk) < NCH ? (chunk) : NCH - 1) * CH + hw * 4 + hi_) * NHR + h] = bs_; } while (0)
#define HREDUCE1(buf, chunk, oi) do { const int s_ = (oi) >> 5, rr_ = (oi) & 31; \
        const LAS f32x4* yp = (const LAS f32x4*)(lds + YP_OFF + (buf) * YP_BYTES) + s_ * 128 + (rr_ >> 3) * 32 + ((rr_ >> 2) & 1) * 16 + (rr_ & 3) * 4; \
        const f32x4 a_ = yp[0], b_ = yp[1], c_ = yp[2], d_ = yp[3]; const f32x4 e_ = (a_ + b_) + (c_ + d_); \
        Y[(size_t)TSTEP((chunk) * CH + s_) * DR + row0 + rr_] = (e_.x + e_.y) + (e_.z + e_.w); } while (0)
#define HREDUCE(buf, chunk) do { HREDUCE1(buf, chunk, hw * 64 + lane); HREDUCE1(buf, chunk, hw * 64 + lane + 256); } while (0)
    const int q = lane & 15, rw = lane >> 4;
    f32x2 A01 = {0.f, 0.f}, A23 = {0.f, 0.f}, B01 = {0.f, 0.f}, B23 = {0.f, 0.f};
    f32x4 cva[8], cvb[8]; int cv_it = CJ.wave_gid;
    int cva_it = CV_ITEMS, cvb_it = CV_ITEMS;
    LAS float* cscr = (LAS float*)(lds + CV_SCR_OFF + hw * CV_SCR_BYTES);
#define CV_DECODE(it, W_, N_, K_, WT_, k0_, n0_, dr_) do { int r_ = (it); if (r_ < 2 * CV_GATE) { const bool up_ = r_ >= CV_GATE; if (up_) r_ -= CV_GATE; W_ = up_ ? CJ.wu : CJ.wg; N_ = FF; K_ = D; WT_ = CJ.WGU2; \
        const int kb_ = r_ / (FF / 32), nb_ = r_ - kb_ * (FF / 32); k0_ = 64 * kb_; n0_ = 32 * nb_; dr_ = 256 * (n0_ >> 7) + (up_ ? 128 : 0) + (n0_ & 127); } \
      else { r_ -= 2 * CV_GATE; W_ = CJ.wd; N_ = D; K_ = FF; WT_ = CJ.WD2; const int kb_ = r_ / (D / 32), nb_ = r_ - kb_ * (D / 32); k0_ = 64 * kb_; n0_ = 32 * nb_; dr_ = n0_; } } while (0)
#define CV_LOAD(REG, HELD) do { HELD = cv_it; if (cv_it < CV_ITEMS) { const float* W_; int N_, K_, k0_, n0_, dr_; bf16* WT_; CV_DECODE(cv_it, W_, N_, K_, WT_, k0_, n0_, dr_); (void)K_; (void)WT_; (void)dr_; \
        const float* src_ = W_ + (size_t)(k0_ + (lane >> 3)) * N_ + n0_ + 4 * (lane & 7); \
        _Pragma("unroll") for (int i = 0; i < 8; ++i) REG[i] = *(const GAS f32x4*)(src_ + (size_t)(8 * i) * N_); \
        const int nx_ = cv_it + CJ.n_waves; cv_it = (cv_it < 2 * CV_GATE && nx_ >= 2 * CV_GATE) ? nx_ + TAIL_WD2 : nx_; } } while (0)
#define CV_STORE(REG, HELD) do { if (HELD < CV_ITEMS) { const float* W_; int N_, K_, k0_, n0_, dr_; bf16* WT_; CV_DECODE(HELD, W_, N_, K_, WT_, k0_, n0_, dr_); (void)W_; (void)N_; \
        _Pragma("unroll") for (int i = 0; i < 8; ++i) { LAS float* d_ = cscr + (8 * i + (lane >> 3)) * 33 + 4 * (lane & 7); d_[0] = REG[i].x; d_[1] = REG[i].y; d_[2] = REG[i].z; d_[3] = REG[i].w; } \
        asm volatile("s_waitcnt lgkmcnt(0)" ::: "memory"); \
        _Pragma("unroll") for (int j = 0; j < 4; ++j) { const int n_ = (lane >> 3) + 8 * j; const LAS float* s_ = cscr + (8 * (lane & 7)) * 33 + n_; \
            v4u o_; o_.x = pk2(s_[0 * 33], s_[1 * 33]); o_.y = pk2(s_[2 * 33], s_[3 * 33]); o_.z = pk2(s_[4 * 33], s_[5 * 33]); o_.w = pk2(s_[6 * 33], s_[7 * 33]); \
            *(GAS v4u*)(WT_ + (size_t)(dr_ + n_) * K_ + k0_ + 8 * (lane & 7)) = o_; } \
        asm volatile("s_waitcnt lgkmcnt(0)" ::: "memory"); HELD = CV_ITEMS; } } while (0)
#define CHUNK_BAR() do { asm volatile("s_waitcnt lgkmcnt(0)" ::: "memory"); __builtin_amdgcn_s_barrier(); asm volatile("" ::: "memory"); } while (0)
#define CHUNK_SCAN(c, BUF) do { if (!(var & 16)) { \
            const LAS f32x4* vec = (const LAS f32x4*)(lds + VEC_OFF + (BUF) * VEC_BYTES) + q; \
            const LAS float* vv = (const LAS float*)(lds + VV_OFF + (BUF) * VV_BYTES) + 8 * (wave & 3) + rw; \
            LAS float* ypw = (LAS float*)(lds + YP_OFF + (BUF) * YP_BYTES) + (wave & 3) * 128 + lane; \
            f32x4 VS[4][5]; float VA[4], VB[4];                     \
            _Pragma("unroll") for (int p = 0; p < 3; ++p) { _Pragma("unroll") for (int e = 0; e < 5; ++e) VS[p][e] = vec[p * 80 + e * 16]; VA[p] = vv[p * 32]; VB[p] = vv[p * 32 + 4]; } \
            _Pragma("unroll") for (int s = 0; s < CH; ++s) { \
                if (s + 3 < CH) { _Pragma("unroll") for (int e = 0; e < 5; ++e) VS[(s + 3) & 3][e] = vec[(s + 3) * 80 + e * 16]; VA[(s + 3) & 3] = vv[(s + 3) * 32]; VB[(s + 3) & 3] = vv[(s + 3) * 32 + 4]; } \
                const f32x4 nkk4 = VS[s & 3][0], w4 = VS[s & 3][1], b4 = VS[s & 3][2], kd4 = VS[s & 3][3], r4 = VS[s & 3][4]; const float va = VA[s & 3], vb = VB[s & 3]; \
                const f32x2 n01 = {nkk4.x, nkk4.y}, n23 = {nkk4.z, nkk4.w}, w01 = {w4.x, w4.y}, w23 = {w4.z, w4.w}, b01 = {b4.x, b4.y}, b23 = {b4.z, b4.w}, k01 = {kd4.x, kd4.y}, k23 = {kd4.z, kd4.w}, r01 = {r4.x, r4.y}, r23 = {r4.z, r4.w}; \
                const f32x2 ppa = A01 * n01 + A23 * n23, ppb = B01 * n01 + B23 * n23; \
                const float saa = row16_sum(ppa.x + ppa.y), sab = row16_sum(ppb.x + ppb.y); \
                const f32x2 sa2 = {saa, saa}, sb2 = {sab, sab}, va2 = {va, va}, vb2 = {vb, vb}; \
                A01 = A01 * w01 + (sa2 * b01 + va2 * k01); A23 = A23 * w23 + (sa2 * b23 + va2 * k23); \
                B01 = B01 * w01 + (sb2 * b01 + vb2 * k01); B23 = B23 * w23 + (sb2 * b23 + vb2 * k23); \
                const f32x2 ya = A01 * r01 + A23 * r23, yb = B01 * r01 + B23 * r23; \
                if (!(var & 8)) { ypw[s * 512] = ya.x + ya.y; ypw[s * 512 + 64] = yb.x + yb.y; } \
            } } \
        CHUNK_BAR(); } while (0)
#define CHUNK_HELP(c, BUF, ST, LD, CONV) do { if (!(var & 32)) { \
            if (!(var & 4)) { HLOAD(LD, ((c) + 4 < NCH ? (c) + 4 : NCH - 1));         \
            HSTAGE(ST, (BUF) ^ 1, (c) + 1); }                                 \
            if (!(var & 2)) HREDUCE((BUF) ^ 1, ((c) >= 1 ? (c) - 1 : 0)); CONV;            \
        } \
        CHUNK_BAR(); } while (0)
    __syncthreads();
    if (wave >= 4) { HLOAD(0, 0); HLOAD(1, 1); HLOAD(2, 2); HLOAD(3, 3); HSTAGE(0, 0, 0); }
    __syncthreads();
    if (wave < 4 || (var & 64)) {
#pragma unroll 1
        for (int c = 0; c < NCH; c += 4) { CHUNK_SCAN(c, 0); CHUNK_SCAN(c + 1, 1); CHUNK_SCAN(c + 2, 0); CHUNK_SCAN(c + 3, 1); }
    } else {
#pragma unroll 1
        for (int c = 0; c < NCH; c += 4) {
            CHUNK_HELP(c, 0, 1, 0, CV_LOAD(cva, cva_it)); CHUNK_HELP(c + 1, 1, 2, 1, CV_LOAD(cvb, cvb_it)); CHUNK_HELP(c + 2, 0, 3, 2, CV_STORE(cva, cva_it)); CHUNK_HELP(c + 3, 1, 0, 3, CV_STORE(cvb, cvb_it)); }
    }
    if (wave >= 4) HREDUCE((NCH - 1) & 1, NCH - 1);
    asm volatile("s_waitcnt vmcnt(0)" ::: "memory");
#undef TSTEP
#undef HLOAD
#undef HSTAGE
#undef HREDUCE
#undef HREDUCE1
#undef CHUNK_SCAN
#undef CHUNK_HELP
#undef CHUNK_BAR
#undef CV_DECODE
#undef CV_LOAD
#undef CV_STORE
#undef DECLSET
}
}

enum { I_X = 0, I_F1_PRE, I_F1_WG, I_F1_WU, I_F1_WD, I_F1_POST, I_MIX_PRE, I_WIN, I_MU_PREV, I_MU_NEXT, I_W0F, I_W2F, I_W0B, I_W2B, I_A0F, I_A2F, I_A0B, I_A2B, I_G2, I_KK, I_KA, I_RK, I_GNW, I_GNB,
       I_LQ1, I_LK1, I_LQ2, I_LK2, I_SUBLN, I_WOUT, I_MIX_POST, I_F2_PRE, I_F2_WG, I_F2_WU, I_F2_WD, I_F2_POST, I_FINAL, N_IN };
constexpr int NORM_W = 32768, QCTR_W = 32768 + 128;
struct Args { const float* in[N_IN]; float* out; unsigned char* ws; int ph_lo, ph_hi, li, pad; };
static_assert(sizeof(Args) == (N_IN + 2) * 8 + 16, "Args has no padding");

__global__ void __launch_bounds__(NWAVES * 64, 2) hyb_fwd(Args args) {
    extern __shared__ __attribute__((aligned(16))) unsigned char lds_raw[];
    LAS unsigned char* lds = (LAS unsigned char*)lds_raw;
    volatile LAS unsigned* MISC = (volatile LAS unsigned*)(lds + MISC_OFF);
    const int tid0 = threadIdx.x;
    const int G = gridDim.x, bx = blockIdx.x, vcu = (G % 8 == 0) ? (bx % 8) * (G / 8) + bx / 8 : bx;
    const int NGW = G * NWAVES;
#define PHASE_IDS() int tid = threadIdx.x; asm volatile("" : "+v"(tid)); const int lane = tid & 63, wave = __builtin_amdgcn_readfirstlane(tid >> 6), gw = vcu * NWAVES + wave; (void)lane; (void)gw; \
    LAS float* const scr = (LAS float*)(lds + RING_OFF + wave * 16384); (void)scr
    unsigned char* ws = args.ws;
    for (int u = tid0; u < (LDS_BYTES - LDSCTL_OFF) / 4; u += NWAVES * 64) ((LAS unsigned*)(lds + LDSCTL_OFF))[u] = 0u;
    __syncthreads();
    const int lo = args.ph_lo, hi = args.ph_hi;
    unsigned* const barw = (unsigned*)(ws + WS_CTL) + 1024 + args.li * 4096;
    XcdBarrier bar; bar.bar = barw; bar.x = 0; bar.st = nullptr;
    if (hi - lo > 1) bar = xcd_barrier_post(barw, MISC + 8);
#if defined(PHASE_MASK)
#define IN(k) (((PHASE_MASK >> (k)) & 1) && lo <= (k) && (k) < hi)
#elif defined(ONLY_PHASE)
#define IN(k) ((k) == ONLY_PHASE && lo <= (k) && (k) < hi)
#else
#define IN(k) (lo <= (k) && (k) < hi)
#endif
#define SEAM(k) do { if (IN(k) && IN((k) + 1)) xcd_barrier(bar); } while (0)
    bf16* const WGU = (bf16*)(ws + WS_WGU); bf16* const WD = (bf16*)(ws + WS_WD); bf16* const WIN = (bf16*)(ws + WS_WIN); bf16* const WOUT = (bf16*)(ws + WS_WOUT);
    bf16* const WGU2 = (bf16*)(ws + WS_WGU2); bf16* const WD2 = (bf16*)(ws + WS_WD2);
    bf16* const W2T = (bf16*)(ws + WS_W2T); bf16* const A2T = (bf16*)(ws + WS_A2T); bf16* const G2T = (bf16*)(ws + WS_G2T);
    bf16* const XN = (bf16*)(ws + WS_XN); bf16* const HID = (bf16*)(ws + WS_HID); bf16* const Fb = (bf16*)(ws + WS_F); bf16* const Hb = (bf16*)(ws + WS_H);
    bf16* const PR = (bf16*)(ws + WS_PR); bf16* const QKV = (bf16*)(ws + WS_QKV);
    bf16* const Rb = (bf16*)(ws + WS_R); bf16* const Kb = (bf16*)(ws + WS_K); bf16* const Vb = (bf16*)(ws + WS_V); bf16* const KKb = (bf16*)(ws + WS_KK);
    bf16* const HWb = (bf16*)(ws + WS_HW); bf16* const XAb = (bf16*)(ws + WS_XA); bf16* const SGb = (bf16*)(ws + WS_SG);
    float* const DECF = (float*)(ws + WS_DECF); float* const DECB = (float*)(ws + WS_DECB); float* const AFb = (float*)(ws + WS_AF); float* const ABb = (float*)(ws + WS_AB); bf16* const Gb = (bf16*)(ws + WS_G);
    float* const BONF = (float*)(ws + WS_BONF); float* const BONB = (float*)(ws + WS_BONB);
    float* const YF = (float*)(ws + WS_YF); float* const YB = (float*)(ws + WS_YB); float* const O1 = (float*)(ws + WS_O1);

    if (IN(0)) { PHASE_IDS();
        conv_mat<1>(args.in[I_F1_WG], D, FF, WGU, scr, gw, NGW, lane);
        conv_mat<2>(args.in[I_F1_WU], D, FF, WGU, scr, gw, NGW, lane);
        conv_mat<0>(args.in[I_F1_WD], FF, D, WD, scr, gw, NGW, lane, G == 256 ? TAIL_WD : 0);
        conv_mat<3>(args.in[I_WIN], D, 12736, WIN, scr, gw, NGW, lane);
        if (G != 256) conv_mat<0>(args.in[I_WOUT], D, D, WOUT, scr, gw, NGW, lane);
        conv_mat<0>(args.in[I_G2], LK, DR, G2T, scr, gw, NGW, lane);
        conv_lora96(args.in[I_W2F], args.in[I_W2B], W2T, vcu * 512 + tid, G * 512);
        conv_lora96(args.in[I_A2F], args.in[I_A2B], A2T, vcu * 512 + tid, G * 512);
        for (int i = vcu * 512 + tid; i < 64 * 4096 / 8; i += G * 512) *(GAS v4u*)(WIN + (size_t)RC * D + (size_t)i * 8) = (v4u){0u, 0u, 0u, 0u};
        for (int m_ = gw; m_ < T; m_ += NGW) { int m = m_; asm volatile("" : "+s"(m)); row_norm_bf16(args.in[I_X] + (size_t)m * D, args.in[I_F1_PRE], XN + (size_t)m * D, (LAS f32x4*)scr, lane); }
    }
    SEAM(0);
    if (IN(1)) { PHASE_IDS(); __syncthreads();
        pg8::Gemm g{XN, WGU, T, 2 * FF, D}; pg8::StaticOrder S; S.init(T, 2 * FF, G, bx); pg8::EpiSwiGLU E{HID, FF};
        pg8::gemm_phase<pg8::EpiSwiGLU, pg8::StaticOrder, true, true>(lds + RING_OFF, g, S, E);
        if (G == 256 && bx >= 192) { __syncthreads(); conv_mat<0>(args.in[I_F1_WD], FF, D, WD, scr, (bx - 192) * NWAVES + wave, 64 * NWAVES, lane, 0, TAIL_WD); } }
    SEAM(1);
    if (IN(2)) { PHASE_IDS(); __syncthreads();
        pg8::Gemm g{HID, WD, T, D, FF}; pg8::StaticOrder S; S.init(T, D, G, bx); pg8::EpiBf16Out E{Fb, D};
        pg8::gemm_phase<pg8::EpiBf16Out, pg8::StaticOrder, true, true>(lds + RING_OFF, g, S, E); }
    SEAM(2);
    if (IN(3)) { PHASE_IDS();
        rr_phase<false, true>(lds + RING_OFF, Fb, args.in[I_X], 0.5f, args.in[I_F1_POST], args.in[I_MIX_PRE], Hb, XN, nullptr, gw, NGW, tid, lane); }
    SEAM(3);
    if (IN(4)) { PHASE_IDS(); __syncthreads();
        pg8::Gemm g{XN, WIN, T, NIN, D}; pg8::StaticOrder S; S.init(T, NIN, G, bx); pg8::EpiIn E{PR, QKV, QSCALE};
        pg8::gemm_phase<pg8::EpiIn, pg8::StaticOrder, true, true>(lds + RING_OFF, g, S, E);
        if (G == 256 && bx >= 64) { __syncthreads(); const int tg = (bx - 64) * NWAVES + wave, tn = 192 * NWAVES;
            conv_mat<0>(args.in[I_WOUT], D, D, WOUT, scr, tg, tn, lane);
            conv_mat<1>(args.in[I_F2_WG], D, FF, WGU2, scr, tg, tn, lane, 0, TAIL_GU); } }
    SEAM(4);
    if (IN(5)) { PHASE_IDS();
        PrepA P{PR, args.in[I_MU_PREV], args.in[I_MU_NEXT], args.in[I_KK], Rb, Kb, Vb, KKb, HWb, XAb, SGb};
        prep_phase(lds + RING_OFF, P, gw, NGW, tid, lane);
        { float mx[8] = {0.f, 0.f, 0.f, 0.f, 0.f, 0.f, 0.f, 0.f};
          qk_norm_rows(QKV, mx, gw, NGW, lane);
          LAS unsigned* nl = (LAS unsigned*)(lds + RING_OFF + 65536);
          if (tid < 64) nl[tid] = 0u;
          __syncthreads();
          if ((lane & 7) == 0) {
#pragma unroll
              for (int j = 0; j < 8; ++j) (void)__hip_atomic_fetch_max(nl + (lane >> 3) + 8 * j, __float_as_uint(mx[j]), __ATOMIC_RELAXED, __HIP_MEMORY_SCOPE_WORKGROUP); }
          __syncthreads();
          if (tid < 64) (void)__hip_atomic_fetch_max((unsigned*)(ws + WS_CTL) + NORM_W + tid, nl[tid], __ATOMIC_RELAXED, __HIP_MEMORY_SCOPE_AGENT);
        }
    }
    SEAM(5);
    if (IN(6)) { PHASE_IDS(); __syncthreads();
#if !defined(P6_ONLY) || P6_ONLY == 0
        { pg8::Gemm g{HWb, W2T, T, 4096, LK}; pg8::StaticOrder S; S.init(T, 4096, G, bx); pg8::EpiLora<0> E{DECF, DECB, args.in[I_W0F], args.in[I_W0B]};
          pg8::gemm_phase<pg8::EpiLora<0>, pg8::StaticOrder, true, true>(lds + RING_OFF, g, S, E); }
#endif
#if !defined(P6_ONLY) || P6_ONLY == 1
        __syncthreads();
        { pg8::Gemm g{XAb, A2T, T, 4096, LK}; pg8::StaticOrder S; S.init(T, 4096, G, bx); pg8::EpiLora<1> E{AFb, ABb, args.in[I_A0F], args.in[I_A0B]};
          pg8::gemm_phase<pg8::EpiLora<1>, pg8::StaticOrder, true, true>(lds + RING_OFF, g, S, E); }
#endif
#if !defined(P6_ONLY) || P6_ONLY == 2
        __syncthreads();
        { pg8::Gemm g{SGb, G2T, T, 2048, LK}; pg8::StaticOrder S; S.init(T, 2048, G, bx); pg8::EpiLora<2> E{Gb, Gb, nullptr, nullptr};
          pg8::gemm_phase<pg8::EpiLora<2>, pg8::StaticOrder, true, true>(lds + RING_OFF, g, S, E); }
#endif
    }
    SEAM(6);
    if (IN(7)) { PHASE_IDS();
        if ((bx < 128 || G != 256) && args.pad != 2) {
            scan::Tensors P{Rb, Kb, KKb, Vb, {DECF, DECB}, {AFb, ABb}, args.in[I_KA], {YF, YB}, args.in[I_RK], {BONF, BONB}};
            const scan::ConvJob CJ{args.in[I_F2_WG], args.in[I_F2_WU], args.in[I_F2_WD], WGU2, WD2, G == 256 ? TAIL_GU + bx * 4 + (wave & 3) : scan::CV_ITEMS, 512};
            const int su0 = (G == 256) ? (bx & 7) * 16 + (bx >> 3) : bx;
            #if defined(PROBE_VARIANT) && PROBE_VARIANT != 0
            if (args.pad != 0) { for (int su = su0; su < 128; su += (G == 256 ? 128 : G)) scan::scan_unit<PROBE_VARIANT>(lds + RING_OFF, P, CJ, su >> 2, (su >> 1) & 1, su & 1, (float*)(ws + WS_X1)); } else
#endif
            for (int su = su0; su < 128; su += (G == 256 ? 128 : G)) scan::scan_unit<0>(lds + RING_OFF, P, CJ, su >> 2, (su >> 1) & 1, su & 1, nullptr);
        }
        const float lam = __uint_as_float(__builtin_amdgcn_readfirstlane(__float_as_uint(__expf(wave_sum(args.in[I_LQ1][lane] * args.in[I_LK1][lane])) - __expf(wave_sum(args.in[I_LQ2][lane] * args.in[I_LK2][lane])) + LAM_INIT)));
        const unsigned* nrm = (const unsigned*)(ws + WS_CTL) + NORM_W;
        for (;;) {
            __syncthreads();
            if (tid == 0) MISC[12] = __hip_atomic_fetch_add((unsigned*)(ws + WS_CTL) + QCTR_W + (args.pad == 2 ? 64 : 0), 1u, __ATOMIC_RELAXED, __HIP_MEMORY_SCOPE_AGENT);
            __syncthreads();
            const int u = __builtin_amdgcn_readfirstlane((int)MISC[12]);
            if (u >= 512) break;
            const int h = 15 - (u >> 5), qb = u & 31;
            const float sl2 = exp2f(-0.5f * (float)(h + 1)) * 1.4426950408889634f;
#define NRM_LD(i) __uint_as_float(__builtin_amdgcn_readfirstlane(__hip_atomic_load(nrm + (i), __ATOMIC_RELAXED, __HIP_MEMORY_SCOPE_AGENT)))
            const float qa = NRM_LD(2 * h), ka = NRM_LD(32 + 2 * h), qb2 = NRM_LD(2 * h + 1), kb2 = NRM_LD(32 + 2 * h + 1);
#undef NRM_LD
#if defined(PROBE_ATTVAR)
            if (args.pad == 2) att::attn_unit<PROBE_ATTVAR>(lds + RING_OFF, QKV, (float*)(ws + WS_X1 + 128 * MiB) + (size_t)bx * 32768, (bf16*)(ws + WS_X1), args.in[I_SUBLN], h, qb * 256, lam, sl2, qa, ka, qb2, kb2); else
#endif
            att::attn_unit<0>(lds + RING_OFF, QKV, O1 + (size_t)bx * 32768, XN, args.in[I_SUBLN], h, qb * 256, lam, sl2, qa, ka, qb2, kb2); }
    }
    SEAM(7);
    if (IN(8)) { PHASE_IDS();
        PostR P{YF, YB, Vb, BONF, BONB, Gb, args.in[I_GNW], args.in[I_GNB], XN};
        for (int t_ = gw; t_ < T; t_ += NGW) { int t = t_; asm volatile("" : "+s"(t)); post_r_row(P, t, lane); }
    }
    SEAM(8);
    if (IN(9)) { PHASE_IDS(); __syncthreads();
        if (G != 256) {
            conv_mat<1>(args.in[I_F2_WG], D, FF, WGU2, scr, gw, NGW, lane);
            conv_mat<2>(args.in[I_F2_WU], D, FF, WGU2, scr, gw, NGW, lane);
            conv_mat<0>(args.in[I_F2_WD], FF, D, WD2, scr, gw, NGW, lane);
            __syncthreads(); }
        pg8::Gemm g{XN, WOUT, T, D, D}; pg8::StaticOrder S; S.init(T, D, G, bx); pg8::EpiBf16Out E{Fb, D};
        pg8::gemm_phase<pg8::EpiBf16Out, pg8::StaticOrder, true, true>(lds + RING_OFF, g, S, E); }
    SEAM(9);
    if (IN(10)) { PHASE_IDS();
        rr_phase<false, false>(lds + RING_OFF, Fb, Hb, 1.0f, args.in[I_MIX_POST], args.in[I_F2_PRE], Hb, XN, nullptr, gw, NGW, tid, lane); }
    SEAM(10);
    if (IN(11)) { PHASE_IDS(); __syncthreads();
        pg8::Gemm g{XN, WGU2, T, 2 * FF, D}; pg8::StaticOrder S; S.init(T, 2 * FF, G, bx); pg8::EpiSwiGLU E{HID, FF};
        pg8::gemm_phase<pg8::EpiSwiGLU, pg8::StaticOrder, true, true>(lds + RING_OFF, g, S, E);
        if (G == 256 && bx >= 192) { __syncthreads(); conv_mat<0>(args.in[I_F2_WD], FF, D, WD2, scr, (bx - 192) * NWAVES + wave, 64 * NWAVES, lane, 0, TAIL_WD2); } }
    SEAM(11);
    if (IN(12)) { PHASE_IDS(); __syncthreads();
        pg8::Gemm g{HID, WD2, T, D, FF}; pg8::StaticOrder S; S.init(T, D, G, bx); pg8::EpiBf16Out E{Fb, D};
        pg8::gemm_phase<pg8::EpiBf16Out, pg8::StaticOrder, true, true>(lds + RING_OFF, g, S, E); }
    SEAM(12);
    if (IN(13)) { PHASE_IDS();
        rr_phase<true, false>(lds + RING_OFF, Fb, Hb, 0.5f, args.in[I_F2_POST], args.in[I_FINAL], nullptr, nullptr, args.out, gw, NGW, tid, lane); }
#undef IN
#undef SEAM
}

extern "C" void kernel_launch(void* const* d_in, const int* in_sizes, int n_in, void* d_out, int out_size, void* d_ws, size_t ws_size, hipStream_t stream) {
    static int grid = 0;
    if (grid == 0) {
        if (n_in != N_IN || in_sizes[0] != T * D || out_size != T * D || ws_size < WS_END) { fprintf(stderr, "kernel_launch: shape/workspace mismatch (n_in %d, in0 %d, out %d, ws %zu, need %zu)\n", n_in, n_in > 0 ? in_sizes[0] : -1, out_size, ws_size, (size_t)WS_END); grid = -1; return; }
        int dev = 0, cus = 0, per_cu = 0;
        if (hipGetDevice(&dev) != hipSuccess || hipDeviceGetAttribute(&cus, hipDeviceAttributeMultiprocessorCount, dev) != hipSuccess) { grid = -1; return; }
        if (hipFuncSetAttribute((const void*)hyb_fwd, hipFuncAttributeMaxDynamicSharedMemorySize, LDS_BYTES) != hipSuccess) { fprintf(stderr, "kernel_launch: hipFuncSetAttribute failed\n"); grid = -1; return; }
        if (hipOccupancyMaxActiveBlocksPerMultiprocessor(&per_cu, (const void*)hyb_fwd, NWAVES * 64, LDS_BYTES) != hipSuccess || per_cu < 1) { fprintf(stderr, "kernel_launch: occupancy query says %d blocks per CU\n", per_cu); (void)hipGetLastError(); grid = -1; return; }
        grid = cus;
    }
    if (grid < 0) return;
    if (hipMemsetAsync((char*)d_ws + WS_CTL, 0, CTL_ZERO_BYTES, stream) != hipSuccess) return;
    Args a{};
    for (int i = 0; i < N_IN; ++i) a.in[i] = (const float*)d_in[i];
    a.out = (float*)d_out; a.ws = (unsigned char*)d_ws;
#if defined(PROBE_REPEAT)
#ifndef PROBE_PAD
#define PROBE_PAD 1
#endif
#ifndef PROBE_DELAY
#define PROBE_DELAY 0
#endif
    a.ph_lo = 0; a.ph_hi = PROBE_REPEAT + 1 + PROBE_DELAY; hipLaunchKernelGGL(hyb_fwd, dim3(grid), dim3(NWAVES * 64), LDS_BYTES, stream, a);
    a.ph_lo = PROBE_REPEAT; a.ph_hi = PROBE_REPEAT + 1; a.li = 1; a.pad = PROBE_PAD; hipLaunchKernelGGL(hyb_fwd, dim3(grid), dim3(NWAVES * 64), LDS_BYTES, stream, a);
    if (PROBE_REPEAT + 1 + PROBE_DELAY < N_PHASES) { a.ph_lo = PROBE_REPEAT + 1 + PROBE_DELAY; a.ph_hi = N_PHASES; a.li = 2; a.pad = 0; hipLaunchKernelGGL(hyb_fwd, dim3(grid), dim3(NWAVES * 64), LDS_BYTES, stream, a); }
#elif MK_ONE_LAUNCH
    a.ph_lo = 0; a.ph_hi = N_PHASES;
    hipLaunchKernelGGL(hyb_fwd, dim3(grid), dim3(NWAVES * 64), LDS_BYTES, stream, a);
#else
    for (int p = 0; p < N_PHASES; ++p) { a.ph_lo = p; a.ph_hi = p + 1; hipLaunchKernelGGL(hyb_fwd, dim3(grid), dim3(NWAVES * 64), LDS_BYTES, stream, a); }
#endif
    const hipError_t le = hipPeekAtLastError();
    if (le != hipSuccess) fprintf(stderr, "kernel_launch: launch failed: %s\n", hipGetErrorName(le));
}
```

```cpp
#include <hip/hip_runtime.h>
#include <cstdio>
#include <cstdint>

constexpr int T = 8192, D = 4096, FF = 11008, DR = 2048, RC = 6592, RCP = 6656, NIN = 12800, QKVW = 6144, NHR = 32, HN = 64, LK = 256;
constexpr int NDH = 16;
constexpr float NORM_EPS = 1e-6f, GN_EPS = 64e-5f, SUBLN_EPS = 1e-5f, LAM_INIT = 0.2f;
constexpr float QSCALE = 0.125f * 1.4426950408889634f;
#ifndef N_PHASES
#define N_PHASES 14
#endif
#ifndef MK_ONE_LAUNCH
#define MK_ONE_LAUNCH 1
#endif

namespace pg8 {
#define PG8_LAS __attribute__((address_space(3)))
typedef unsigned short bf16_t;
typedef short bf16x8 __attribute__((ext_vector_type(8)));
typedef float f32x4 __attribute__((ext_vector_type(4)));
typedef unsigned u32x4 __attribute__((ext_vector_type(4)));
constexpr int BM = 256, BK = 64, HALF = 128, HTB = HALF * BK * 2  , STAGE_BYTES = 8 * HTB, NXCD = 8, WGM = 8;

__host__ __device__ __forceinline__ int lds_byte(int r, int c) { const int st = (r >> 4) * 2 + (c >> 5), rr = r & 15, cc = c & 31, ob = rr * 64 + cc * 2; return st * 1024 + (ob ^ (((ob >> 9) & 1) << 5)); }
__host__ __device__ __forceinline__ void stage_rc(int b, int& R, int& C) { const int st = b / 1024, sb = b % 1024, swz = sb ^ (((sb >> 9) & 1) << 5); R = (st >> 1) * 16 + swz / 64; C = (st & 1) * 32 + (swz % 64) / 2; }
__host__ __device__ __forceinline__ int perm32(int rho) { const int n = rho >> 4, i = rho & 15; return 8 * (i >> 2) + 4 * n + (i & 3); }

struct Unit { int pm, pn; };
struct Gemm { const bf16_t* A; const bf16_t* Bt; int M, N, K; };

struct StaticOrder {
    int nM, nN, nwg, G, c;
    __host__ __device__ void init(int M, int N, int G_, int c_) { nM = M / BM; nN = N / BM; nwg = nM * nN; G = G_; c = c_; }
    __host__ __device__ bool next(int i, Unit& u) const {
        const long L = (long)i * G + c; if (L >= nwg) return false;
        int wgid = (int)L; { const int q = nwg / NXCD, r = nwg % NXCD, xcd = wgid % NXCD, off = wgid / NXCD; wgid = (xcd < r ? xcd * (q + 1) : r * (q + 1) + (xcd - r) * q) + off; }
        const int nig = WGM * nN, gid = wgid / nig, fm = gid * WGM, gsz = (nM - fm) < WGM ? (nM - fm) : WGM;
        u.pm = fm + ((wgid % nig) % gsz); u.pn = (wgid % nig) / gsz; return true;
    }
    __device__ __forceinline__ void a_ready(const Unit&) const {}
    __device__ __forceinline__ void done(const Unit&) const {}
};

__device__ __forceinline__ unsigned cvt_pk_bf16(float lo, float hi) { unsigned r; asm volatile("v_cvt_pk_bf16_f32 %0, %1, %2" : "=v"(r) : "v"(lo), "v"(hi)); return r; }
typedef unsigned u32x2 __attribute__((ext_vector_type(2)));
__device__ __forceinline__ float sigmoid_f(float x) { return __builtin_amdgcn_rcpf(1.0f + __builtin_amdgcn_exp2f(-1.4426950408889634f * x)); }

struct EpiF32 {
    static constexpr bool PERM = false, AFTER_DRAIN = false;
    float* C; int ldc;
    __device__ __forceinline__ void operator()(const f32x4 (&acc)[2][2][4][2], const Unit& u, int wr, int wc, int fr, int fq) const {
        const int row0 = u.pm * BM + wr * 64 + fr, col0 = u.pn * BM + wc * 32 + 4 * fq;
#pragma unroll
        for (int ai = 0; ai < 2; ++ai)
#pragma unroll
            for (int m = 0; m < 4; ++m) { float* rowp = C + (size_t)(row0 + ai * HALF + m * 16) * ldc + col0;
#pragma unroll
                for (int bj = 0; bj < 2; ++bj)
#pragma unroll
                    for (int n = 0; n < 2; ++n) *(f32x4*)(rowp + bj * HALF + n * 16) = acc[ai][bj][m][n]; }
    }
};
struct EpiBf16Out {
    static constexpr bool PERM = true, AFTER_DRAIN = false;
    bf16_t* O; int ldc;
    __device__ __forceinline__ void operator()(const f32x4 (&acc)[2][2][4][2], const Unit& u, int wr, int wc, int fr, int fq) const {
        const int row0 = u.pm * BM + wr * 64 + fr, col0 = u.pn * BM + wc * 32 + 8 * fq;
#pragma unroll
        for (int ai = 0; ai < 2; ++ai)
#pragma unroll
            for (int m = 0; m < 4; ++m) { bf16_t* rowp = O + (size_t)(row0 + ai * HALF + m * 16) * ldc + col0;
#pragma unroll
                for (int bj = 0; bj < 2; ++bj) { const f32x4 v0 = acc[ai][bj][m][0], v1 = acc[ai][bj][m][1];
                    u32x4 w; w.x = cvt_pk_bf16(v0[0], v0[1]); w.y = cvt_pk_bf16(v0[2], v0[3]); w.z = cvt_pk_bf16(v1[0], v1[1]); w.w = cvt_pk_bf16(v1[2], v1[3]);
                    *(u32x4*)(rowp + bj * HALF) = w; } }
    }
};
struct EpiSwiGLU {
    static constexpr bool PERM = true, AFTER_DRAIN = false;
    bf16_t* O; int ldc;
    __device__ __forceinline__ void operator()(const f32x4 (&acc)[2][2][4][2], const Unit& u, int wr, int wc, int fr, int fq) const {
        const int row0 = u.pm * BM + wr * 64 + fr, col0 = u.pn * HALF + wc * 32 + 8 * fq;
#pragma unroll
        for (int ai = 0; ai < 2; ++ai)
#pragma unroll
            for (int m = 0; m < 4; ++m) { bf16_t* rowp = O + (size_t)(row0 + ai * HALF + m * 16) * ldc + col0;
                float v[8];
#pragma unroll
                for (int n = 0; n < 2; ++n)
#pragma unroll
                    for (int j = 0; j < 4; ++j) { const float g = acc[ai][0][m][n][j], up = acc[ai][1][m][n][j]; v[n * 4 + j] = g * sigmoid_f(g) * up; }
                u32x4 w; w.x = cvt_pk_bf16(v[0], v[1]); w.y = cvt_pk_bf16(v[2], v[3]); w.z = cvt_pk_bf16(v[4], v[5]); w.w = cvt_pk_bf16(v[6], v[7]);
                *(u32x4*)rowp = w; }
    }
};
struct EpiIn {
    static constexpr bool PERM = false, AFTER_DRAIN = false;
    bf16_t* PR; bf16_t* QKV; float qs;
    __device__ __forceinline__ void operator()(const f32x4 (&acc)[2][2][4][2], const Unit& u, int wr, int wc, int fr, int fq) const {
        const int row0 = u.pm * BM + wr * 64 + fr; const bool rw = u.pn < 26;
        const int pc = rw ? u.pn : u.pn - 26, col0 = pc * BM + wc * 32 + 4 * fq, ld = rw ? 6656 : 6144; const float s = (!rw && pc < 8) ? qs : 1.0f;
        bf16_t* base = rw ? PR : QKV;
#pragma unroll
        for (int ai = 0; ai < 2; ++ai)
#pragma unroll
            for (int m = 0; m < 4; ++m) { bf16_t* rowp = base + (size_t)(row0 + ai * HALF + m * 16) * ld + col0;
#pragma unroll
                for (int bj = 0; bj < 2; ++bj)
#pragma unroll
                    for (int n = 0; n < 2; ++n) { const f32x4 v = acc[ai][bj][m][n] * s; u32x2 w; w.x = cvt_pk_bf16(v[0], v[1]); w.y = cvt_pk_bf16(v[2], v[3]);
                        *(u32x2*)(rowp + bj * HALF + n * 16) = w; } }
    }
};
template <int MODE> struct EpiLora {
    static constexpr bool PERM = false, AFTER_DRAIN = false;
    void* Of; void* Ob; const float* bf; const float* bb;
    __device__ __forceinline__ void operator()(const f32x4 (&acc)[2][2][4][2], const Unit& u, int wr, int wc, int fr, int fq) const {
        const int row0 = u.pm * BM + wr * 64 + fr; const bool back = u.pn >= 8; const int pc = back ? u.pn - 8 : u.pn, col0 = pc * BM + wc * 32 + 4 * fq;
        void* O = back ? Ob : Of; const float* bias = back ? bb : bf;
#pragma unroll
        for (int bj = 0; bj < 2; ++bj)
#pragma unroll
            for (int n = 0; n < 2; ++n) {
                const f32x4 bv = (MODE == 2) ? (f32x4){0.f, 0.f, 0.f, 0.f} : *(const f32x4*)(bias + col0 + bj * HALF + n * 16);
#pragma unroll
                for (int ai = 0; ai < 2; ++ai)
#pragma unroll
                    for (int m = 0; m < 4; ++m) { const size_t off = (size_t)(row0 + ai * HALF + m * 16) * 2048 + col0 + bj * HALF + n * 16;
                        f32x4 v = acc[ai][bj][m][n] + bv;
                        if (MODE == 0) {
#pragma unroll
                            for (int j = 0; j < 4; ++j) v[j] = __builtin_amdgcn_exp2f(-0.60653065971f * 1.4426950408889634f * sigmoid_f(v[j]));
                            *(f32x4*)((float*)O + off) = v; }
                        else if (MODE == 1) {
#pragma unroll
                                for (int j = 0; j < 4; ++j) v[j] = sigmoid_f(v[j]);
                            *(f32x4*)((float*)O + off) = v; }
                        else {
                            u32x2 w; w.x = cvt_pk_bf16(v[0], v[1]); w.y = cvt_pk_bf16(v[2], v[3]); *(u32x2*)((bf16_t*)O + off) = w; } }
                asm volatile("" ::: "memory"); }
    }
};

template <class Epi, class Sched, bool ALIGN_EPI = false, bool SP2 = false>
__device__ __forceinline__ void gemm_phase(PG8_LAS unsigned char* lds, const Gemm g, const Sched& S, const Epi& E) {
    int tid_ = threadIdx.x; asm volatile("" : "+v"(tid_));
    const int tid = tid_, wid = __builtin_amdgcn_readfirstlane(tid >> 6), lane = tid & 63, wr = wid >> 2, wc = wid & 3, fr = lane & 15, fq = lane >> 4;
    const int K = g.K, nt = K / BK;
    unsigned voffA[2], voffB[2];
#pragma unroll
    for (int i = 0; i < 2; ++i) { int R, C; stage_rc(tid * 16 + i * 8192, R, C); const int Rb = Epi::PERM ? ((R & ~31) + perm32(R & 31)) : R;
        voffA[i] = (unsigned)(R * K + C) * 2u; voffB[i] = (unsigned)(Rb * K + C) * 2u; }
    const size_t kstep = (size_t)(BK * 2);
    const size_t hstep = (size_t)HALF * K * 2;
    const size_t tstep = 2 * hstep;
    const unsigned ldsw = (unsigned)wid * 1024u;
    const int aoff = lds_byte(wr * 64 + fr, fq * 8), boff = lds_byte(wc * 32 + fr, fq * 8);
#define PG8_SA(b, h) (((b) * 2 + (h)) * HTB)
#define PG8_SB(b, h) ((4 + (b) * 2 + (h)) * HTB)
#define PG8_STAGE(bufoff, gbase, voff) do { _Pragma("unroll") for (int _i = 0; _i < 2; ++_i) \
        __builtin_amdgcn_global_load_lds((const unsigned*)((const char*)(gbase) + (voff)[_i]), (PG8_LAS unsigned*)(lds + (bufoff) + ldsw + _i * 8192), 16, 0, 0); } while (0)
#define PG8_LDA(dst, b, h) do { _Pragma("unroll") for (int m = 0; m < 4; ++m) _Pragma("unroll") for (int k = 0; k < 2; ++k) dst[m][k] = *(const PG8_LAS bf16x8*)(lds + PG8_SA(b, h) + aoff + m * 2048 + k * 1024); } while (0)
#define PG8_LDB(dst, b, h) do { _Pragma("unroll") for (int n = 0; n < 2; ++n) _Pragma("unroll") for (int k = 0; k < 2; ++k) dst[n][k] = *(const PG8_LAS bf16x8*)(lds + PG8_SB(b, h) + boff + n * 2048 + k * 1024); } while (0)
#define PG8_MMA(ai, bj, At, Bt) do { __builtin_amdgcn_s_setprio(1); _Pragma("unroll") for (int m = 0; m < 4; ++m) _Pragma("unroll") for (int n = 0; n < 2; ++n) _Pragma("unroll") for (int k = 0; k < 2; ++k) \
        acc[ai][bj][m][n] = __builtin_amdgcn_mfma_f32_16x16x32_bf16(Bt[n][k], At[m][k], acc[ai][bj][m][n], 0, 0, 0); __builtin_amdgcn_s_setprio(0); } while (0)
#define PG8_WAIT_V(n) asm volatile("s_waitcnt vmcnt(" #n ")" ::: "memory")
#define PG8_WAIT_L(n) asm volatile("s_waitcnt lgkmcnt(" #n ")" ::: "memory")
#define PG8_BAR __builtin_amdgcn_s_barrier()
#define PG8_SCHED __builtin_amdgcn_sched_barrier(0)
    Unit cur, nxt; int ui = 0;
    if (!S.next(0, cur)) return;
    f32x4 acc[2][2][4][2];
#pragma unroll
    for (int a = 0; a < 2; ++a)
#pragma unroll
        for (int b = 0; b < 2; ++b)
#pragma unroll
            for (int m = 0; m < 4; ++m)
#pragma unroll
                for (int n = 0; n < 2; ++n) acc[a][b][m][n] = (f32x4){0.f, 0.f, 0.f, 0.f};
    bf16x8 At[4][2], B0[2][2], B1[2][2];
    const char* cA = (const char*)g.A + (size_t)cur.pm * tstep; const char* cB = (const char*)g.Bt + (size_t)cur.pn * tstep;
    S.a_ready(cur);
    if constexpr (SP2) {
        PG8_STAGE(PG8_SB(0, 0), cB, voffB); PG8_STAGE(PG8_SB(0, 1), cB + hstep, voffB); PG8_STAGE(PG8_SA(0, 0), cA, voffA); PG8_STAGE(PG8_SA(0, 1), cA + hstep, voffA);
        if (wr == 1) PG8_BAR;
        PG8_WAIT_V(2); PG8_BAR;
        PG8_STAGE(PG8_SB(1, 0), cB + kstep, voffB); PG8_STAGE(PG8_SA(1, 0), cA + kstep, voffA); PG8_STAGE(PG8_SB(1, 1), cB + hstep + kstep, voffB);
        PG8_WAIT_V(6); PG8_BAR;
    } else {
        PG8_STAGE(PG8_SB(0, 0), cB, voffB); PG8_STAGE(PG8_SA(0, 0), cA, voffA); PG8_STAGE(PG8_SB(0, 1), cB + hstep, voffB); PG8_STAGE(PG8_SA(0, 1), cA + hstep, voffA);
        if (wr == 1) PG8_BAR;
        PG8_WAIT_V(4); PG8_BAR;
        PG8_STAGE(PG8_SB(1, 0), cB + kstep, voffB); PG8_STAGE(PG8_SA(1, 0), cA + kstep, voffA); PG8_STAGE(PG8_SB(1, 1), cB + hstep + kstep, voffB);
        PG8_WAIT_V(6); PG8_BAR;
    }
    for (;;) {
        const bool has_next = S.next(ui + 1, nxt);
        const char* nA = has_next ? (const char*)g.A + (size_t)nxt.pm * tstep : cA; const char* nB = has_next ? (const char*)g.Bt + (size_t)nxt.pn * tstep : cB;
_Pragma("unroll 1")
        for (int t = 0; t < nt; t += 2) {
            const bool last = (t == nt - 2);
            const char* a1 = cA + (size_t)(t + 1) * kstep;
            const char* a2 = last ? nA : cA + (size_t)(t + 2) * kstep; const char* b2 = last ? nB : cB + (size_t)(t + 2) * kstep;
            const char* a3 = a2 + kstep; const char* b3 = b2 + kstep;
            if (last && has_next) S.a_ready(nxt);
            if constexpr (SP2) {
            PG8_LDB(B0, 0, 0); PG8_LDB(B1, 0, 1); PG8_SCHED; PG8_LDA(At, 0, 0); PG8_STAGE(PG8_SA(1, 1), a1 + hstep, voffA);
            PG8_WAIT_V(8); PG8_WAIT_L(0); PG8_BAR; PG8_MMA(0, 0, At, B0); PG8_MMA(0, 1, At, B1); PG8_BAR; PG8_SCHED;
            PG8_LDA(At, 0, 1); PG8_STAGE(PG8_SB(0, 0), b2, voffB); PG8_STAGE(PG8_SB(0, 1), b2 + hstep, voffB); PG8_STAGE(PG8_SA(0, 0), a2, voffA);
            PG8_WAIT_V(8); PG8_WAIT_L(0); PG8_BAR; PG8_MMA(1, 0, At, B0); PG8_MMA(1, 1, At, B1); PG8_BAR; PG8_SCHED;
            PG8_LDB(B0, 1, 0); PG8_LDB(B1, 1, 1); PG8_SCHED; PG8_LDA(At, 1, 0); PG8_STAGE(PG8_SA(0, 1), a2 + hstep, voffA);
            PG8_WAIT_V(8); PG8_WAIT_L(0); PG8_BAR; PG8_MMA(0, 0, At, B0); PG8_MMA(0, 1, At, B1); PG8_BAR; PG8_SCHED;
            PG8_LDA(At, 1, 1); PG8_STAGE(PG8_SB(1, 0), b3, voffB); PG8_STAGE(PG8_SB(1, 1), b3 + hstep, voffB); PG8_STAGE(PG8_SA(1, 0), a3, voffA);
            PG8_WAIT_V(8); PG8_WAIT_L(0); PG8_BAR; PG8_MMA(1, 0, At, B0); PG8_MMA(1, 1, At, B1); PG8_BAR; PG8_SCHED;
            } else {
            PG8_LDB(B0, 0, 0); PG8_SCHED; PG8_LDA(At, 0, 0); PG8_STAGE(PG8_SA(1, 1), a1 + hstep, voffA);
            PG8_WAIT_L(8); PG8_BAR; PG8_WAIT_L(0); PG8_MMA(0, 0, At, B0); PG8_BAR; PG8_SCHED;
            PG8_LDB(B1, 0, 1); PG8_STAGE(PG8_SB(0, 0), b2, voffB);
            PG8_BAR; PG8_WAIT_L(0); PG8_MMA(0, 1, At, B1); PG8_BAR;
            PG8_LDA(At, 0, 1); PG8_STAGE(PG8_SA(0, 0), a2, voffA);
            PG8_BAR; PG8_WAIT_L(0); PG8_MMA(1, 0, At, B0); PG8_BAR; PG8_SCHED;
            PG8_STAGE(PG8_SB(0, 1), b2 + hstep, voffB);
            PG8_WAIT_V(6); PG8_BAR; PG8_MMA(1, 1, At, B1); PG8_BAR;
            PG8_LDB(B0, 1, 0); PG8_SCHED; PG8_LDA(At, 1, 0); PG8_STAGE(PG8_SA(0, 1), a2 + hstep, voffA);
            PG8_WAIT_L(8); PG8_BAR; PG8_WAIT_L(0); PG8_MMA(0, 0, At, B0); PG8_BAR; PG8_SCHED;
            PG8_LDB(B1, 1, 1); PG8_STAGE(PG8_SB(1, 0), b3, voffB);
            PG8_BAR; PG8_WAIT_L(0); PG8_MMA(0, 1, At, B1); PG8_BAR;
            PG8_LDA(At, 1, 1); PG8_STAGE(PG8_SA(1, 0), a3, voffA);
            PG8_BAR; PG8_WAIT_L(0); PG8_MMA(1, 0, At, B0); PG8_BAR; PG8_SCHED;
            PG8_STAGE(PG8_SB(1, 1), b3 + hstep, voffB);
            PG8_WAIT_V(6); PG8_BAR; PG8_MMA(1, 1, At, B1); PG8_BAR;
            }
        }
        if constexpr (ALIGN_EPI) { if (wr == 0) PG8_BAR; }
        if constexpr (!Epi::AFTER_DRAIN) { E(acc, cur, wr, wc, fr, fq); S.done(cur); }
        if (!has_next) break;
#pragma unroll
        for (int a = 0; a < 2; ++a)
#pragma unroll
            for (int b = 0; b < 2; ++b)
#pragma unroll
                for (int m = 0; m < 4; ++m)
#pragma unroll
                    for (int n = 0; n < 2; ++n) acc[a][b][m][n] = (f32x4){0.f, 0.f, 0.f, 0.f};
        cur = nxt; cA = nA; cB = nB; ++ui;
        if constexpr (ALIGN_EPI) { if (wr == 1) PG8_BAR; }
    }
    PG8_WAIT_V(0);
    if constexpr (!ALIGN_EPI) { if (wr == 0) PG8_BAR; }
    PG8_BAR;
    if constexpr (Epi::AFTER_DRAIN) { E.fused(acc, cur, wr, wc, fr, fq, lds, wid, lane); S.done(cur); }
#undef PG8_SA
#undef PG8_SB
#undef PG8_STAGE
#undef PG8_LDA
#undef PG8_LDB
#undef PG8_MMA
#undef PG8_WAIT_V
#undef PG8_WAIT_L
#undef PG8_BAR
#undef PG8_SCHED
}
}

constexpr size_t MiB = 1u << 20;
constexpr size_t WS_CTL = 0, CTL_ZERO_BYTES = 1 * MiB;
constexpr size_t WS_WGU = 1 * MiB, WS_WD = 173 * MiB;
constexpr size_t WS_WIN = 259 * MiB, WS_WOUT = 359 * MiB;
constexpr int TAIL_WD = 9216, TAIL_GU = 12288, TAIL_WD2 = 9216;
constexpr size_t WS_W2T = 391 * MiB, WS_A2T = 393 * MiB, WS_G2T = 395 * MiB;
constexpr size_t WS_XN = 396 * MiB;
constexpr size_t WS_HID = 460 * MiB;
constexpr size_t WS_F = 632 * MiB;
constexpr size_t WS_H = 760 * MiB;
constexpr size_t WS_X1 = 888 * MiB;
constexpr size_t WS_WGU2 = 1208 * MiB, WS_WD2 = WS_WIN;
constexpr size_t WS_END = 1380 * MiB;
constexpr size_t WS_R = 1 * MiB, WS_K = 65 * MiB, WS_V = 129 * MiB, WS_KK = 193 * MiB;
constexpr size_t WS_QKV = WS_HID, WS_YF = WS_HID + 96 * MiB, WS_HW = WS_HID + 160 * MiB, WS_XA = WS_HID + 164 * MiB, WS_SG = WS_HID + 168 * MiB;
constexpr size_t WS_YB = WS_F, WS_O1 = WS_F + 64 * MiB;
constexpr size_t WS_BONF = WS_HW, WS_BONB = WS_HW + 2 * MiB;
constexpr size_t WS_PR = WS_X1, WS_DECF = WS_X1, WS_DECB = WS_X1 + 64 * MiB, WS_AF = WS_X1 + 128 * MiB, WS_AB = WS_X1 + 192 * MiB, WS_G = WS_X1 + 256 * MiB;

constexpr int NWAVES = 8;
constexpr int RING_OFF = 0, RING_BYTES = 131072;
constexpr int LDSCTL_OFF = RING_BYTES, MISC_OFF = 146944;
constexpr int LDS_BYTES = 147456;

#define GAS __attribute__((address_space(1)))
#define LAS __attribute__((address_space(3)))
typedef unsigned short bf16;
typedef unsigned v4u __attribute__((ext_vector_type(4)));
typedef unsigned v2u __attribute__((ext_vector_type(2)));
typedef float f32x4 __attribute__((ext_vector_type(4)));
typedef float f32x2 __attribute__((ext_vector_type(2)));
typedef short bf16x8 __attribute__((ext_vector_type(8)));
typedef GAS unsigned gu32;
#define RLX_AGENT __ATOMIC_RELAXED, __HIP_MEMORY_SCOPE_AGENT
#define LDS_WAIT() asm volatile("s_waitcnt lgkmcnt(0)" ::: "memory")
#define VM_WAIT() asm volatile("s_waitcnt vmcnt(0)" ::: "memory")
__device__ __forceinline__ unsigned pk2(float lo, float hi) { unsigned r; asm volatile("v_cvt_pk_bf16_f32 %0, %1, %2" : "=v"(r) : "v"(lo), "v"(hi)); return r; }
__device__ __forceinline__ float sigm(float x) { return __builtin_amdgcn_rcpf(1.0f + __builtin_amdgcn_exp2f(-1.4426950408889634f * x)); }
#define XB_TMO      128
#define XB_XCNT(j)  (256  + 64 * (j))
#define XB_XSUB(j)  (1280 + 64 * (j))
#define XB_XGEN(j)  (2304 + 64 * (j))
#define XB_TOP      3328
#define XB_TOPGEN   3392
#define XCD_BAR_WORDS 3456
#define XB_SPIN_CAP (1u << 18)

__device__ __forceinline__ unsigned xb_ld(unsigned* p)              { return __hip_atomic_load(p, __ATOMIC_RELAXED, __HIP_MEMORY_SCOPE_AGENT); }
__device__ __forceinline__ unsigned xb_add(unsigned* p, unsigned v) { return __hip_atomic_fetch_add(p, v, __ATOMIC_RELAXED, __HIP_MEMORY_SCOPE_AGENT); }
__device__ __forceinline__ unsigned xb_xcc_id() { return (unsigned)__builtin_amdgcn_s_getreg((3 << 11) | 20) & 0xFu; }
#define XB_SPIN(cond, bar) do { unsigned _sp = 0; while (cond) { __builtin_amdgcn_s_sleep(1); \
    if ((++_sp & 255u) == 0u) { if (xb_ld(&(bar)[XB_TMO])) break; if (_sp > XB_SPIN_CAP) { atomicAdd(&(bar)[XB_TMO], 1u); break; } } } } while (0)

struct XcdBarrier {
    unsigned* bar; unsigned x;
    volatile LAS unsigned* st;
};

__device__ __forceinline__ XcdBarrier xcd_barrier_post(unsigned* bar, volatile LAS unsigned* st) {
    XcdBarrier b; b.bar = bar; b.x = xb_xcc_id(); b.st = st;
    if (threadIdx.x == 0) (void)xb_add(&bar[XB_XCNT(b.x)], 1u);
    return b;
}
__device__ __forceinline__ void xcd_barrier_complete(unsigned* bar, unsigned x, unsigned& nloc, unsigned& nx) {
    const unsigned G = gridDim.x * gridDim.y * gridDim.z;
    unsigned sum, cnt, mine, sp = 0u;
    for (;;) {
        sum = 0u; cnt = 0u; mine = 0u;
#pragma unroll
        for (unsigned j = 0; j < 16; ++j) { const unsigned c = xb_ld(&bar[XB_XCNT(j)]); sum += c; cnt += (c > 0u) ? 1u : 0u; mine = (j == x) ? c : mine; }
        if (sum == G) break;
        __builtin_amdgcn_s_sleep(1);
        if ((++sp & 255u) == 0u) { if (xb_ld(&bar[XB_TMO])) break; if (sp > XB_SPIN_CAP) { atomicAdd(&bar[XB_TMO], 1u); break; } }
    }
    nloc = mine > 0u ? mine : 1u; nx = cnt > 0u ? cnt : 1u;
}

__device__ __forceinline__ void xcd_barrier(const XcdBarrier& b) {
    asm volatile("s_waitcnt vmcnt(0)" ::: "memory");
    __syncthreads();
    if (threadIdx.x == 0) {
        unsigned* bar = b.bar;
        __builtin_amdgcn_s_waitcnt(0);
        unsigned nloc = b.st[0], nx = b.st[1];
        if (nloc == 0u) { xcd_barrier_complete(bar, b.x, nloc, nx); b.st[0] = nloc; b.st[1] = nx; }
        const unsigned old = xb_add(&bar[XB_XSUB(b.x)], 1u);
        const unsigned gen = old / nloc;
        if (old + 1u == (gen + 1u) * nloc) {
            __builtin_amdgcn_fence(__ATOMIC_RELEASE, "agent");
            asm volatile("s_waitcnt vmcnt(0)" ::: "memory");
            const unsigned og = xb_add(&bar[XB_TOP], 1u);
            const unsigned tg = og / nx;
            if (og + 1u == (tg + 1u) * nx) xb_add(&bar[XB_TOPGEN], 1u);
            else XB_SPIN(xb_ld(&bar[XB_TOPGEN]) == tg, bar);
            __builtin_amdgcn_fence(__ATOMIC_ACQUIRE, "agent");
            xb_add(&bar[XB_XGEN(b.x)], 1u);
            asm volatile("s_waitcnt vmcnt(0)" ::: "memory");
        } else {
            XB_SPIN(xb_ld(&bar[XB_XGEN(b.x)]) == gen, bar);
            __builtin_amdgcn_fence(__ATOMIC_ACQUIRE, "agent");
            asm volatile("s_waitcnt vmcnt(0)" ::: "memory");
        }
    }
    __syncthreads();
}

__device__ __forceinline__ float wave_sum(float v) {
#pragma unroll
    for (int o = 1; o < 64; o <<= 1) v += __shfl_xor(v, o);
    return v;
}
template <int N> __device__ __forceinline__ float dpp_ror(float x) { return __int_as_float(__builtin_amdgcn_update_dpp(0, __float_as_int(x), 0x120 + N, 0xf, 0xf, false)); }
__device__ __forceinline__ float row16_sum(float x) { x += dpp_ror<8>(x); x += dpp_ror<4>(x); x += dpp_ror<2>(x); x += dpp_ror<1>(x); return x; }
__device__ __forceinline__ float sum4(f32x4 v) { return (v.x + v.y) + (v.z + v.w); }
__device__ __forceinline__ float dot4(f32x4 a, f32x4 b) { return (a.x * b.x + a.y * b.y) + (a.z * b.z + a.w * b.w); }
__device__ __forceinline__ float ld_sc1(const float* p) { return __hip_atomic_load(p, __ATOMIC_RELAXED, __HIP_MEMORY_SCOPE_AGENT); }

__device__ __forceinline__ void transpose_item(const float* W, int K, int N, bf16* WT, int dst_row0, LAS float* scr, int k0, int n0, int lane) {
    const float* src = W + (size_t)(k0 + (lane >> 3)) * N + n0 + 4 * (lane & 7);
    f32x4 v[8];
#pragma unroll
    for (int i = 0; i < 8; ++i) v[i] = *(const GAS f32x4*)(src + (size_t)(8 * i) * N);
#pragma unroll
    for (int i = 0; i < 8; ++i) { LAS float* d = scr + (8 * i + (lane >> 3)) * 33 + 4 * (lane & 7); d[0] = v[i].x; d[1] = v[i].y; d[2] = v[i].z; d[3] = v[i].w; }
    LDS_WAIT(); asm volatile("" ::: "memory");
    const int c = lane & 7;
#pragma unroll
    for (int j = 0; j < 4; ++j) { const int n = (lane >> 3) + 8 * j; const LAS float* s = scr + (8 * c) * 33 + n;
        v4u o; o.x = pk2(s[0 * 33], s[1 * 33]); o.y = pk2(s[2 * 33], s[3 * 33]); o.z = pk2(s[4 * 33], s[5 * 33]); o.w = pk2(s[6 * 33], s[7 * 33]);
        *(GAS v4u*)(WT + (size_t)(dst_row0 + n) * K + k0 + 8 * c) = o; }
    LDS_WAIT(); asm volatile("" ::: "memory");
}
template <int MAP> __device__ __forceinline__ void conv_mat(const float* W, int K, int N, bf16* WT, LAS float* scr, int gw, int NGW, int lane, int it_lo = 0, int it_hi = 0x7fffffff) {
    const int nblk = N / 32, nall = (K / 64) * nblk, nitems = nall < it_hi ? nall : it_hi;
    int it = it_lo + gw;
    if (it >= nitems) return;
    const int last = it + ((nitems - 1 - it) / NGW) * NGW;
    f32x4 va[8], vb[8], vc[8], vd[8];
#define CM_LOAD(V, IT) do { const int i_ = (IT) < last ? (IT) : last; const int kb_ = i_ / nblk, nb_ = i_ - kb_ * nblk; \
        const float* src_ = W + (size_t)(64 * kb_ + (lane >> 3)) * N + 32 * nb_ + 4 * (lane & 7); \
        _Pragma("unroll") for (int i = 0; i < 8; ++i) V[i] = *(const GAS f32x4*)(src_ + (size_t)(8 * i) * N); } while (0)
#define CM_STORE(V, IT) do { const int kb_ = (IT) / nblk, nb_ = (IT) - kb_ * nblk, n0_ = 32 * nb_, k0_ = 64 * kb_; int dr_ = n0_; \
        if (MAP == 1) dr_ = 256 * (n0_ >> 7) + (n0_ & 127); \
        if (MAP == 2) dr_ = 256 * (n0_ >> 7) + 128 + (n0_ & 127); \
        if (MAP == 3) dr_ = n0_ < RC ? n0_ : n0_ + (RCP - RC); \
        _Pragma("unroll") for (int i = 0; i < 8; ++i) { LAS float* d_ = scr + (8 * i + (lane >> 3)) * 33 + 4 * (lane & 7); d_[0] = V[i].x; d_[1] = V[i].y; d_[2] = V[i].z; d_[3] = V[i].w; } \
        LDS_WAIT(); asm volatile("" ::: "memory"); \
        _Pragma("unroll") for (int j = 0; j < 4; ++j) { const int n_ = (lane >> 3) + 8 * j; const LAS float* s_ = scr + (8 * (lane & 7)) * 33 + n_; \
            v4u o_; o_.x = pk2(s_[0 * 33], s_[1 * 33]); o_.y = pk2(s_[2 * 33], s_[3 * 33]); o_.z = pk2(s_[4 * 33], s_[5 * 33]); o_.w = pk2(s_[6 * 33], s_[7 * 33]); \
            *(GAS v4u*)(WT + (size_t)(dr_ + n_) * K + k0_ + 8 * (lane & 7)) = o_; } \
        LDS_WAIT(); asm volatile("" ::: "memory"); } while (0)
    CM_LOAD(va, it); CM_LOAD(vb, it + NGW); CM_LOAD(vc, it + 2 * NGW);
    for (; it <= last; it += 4 * NGW) {
        CM_LOAD(vd, it + 3 * NGW); CM_STORE(va, it);
        CM_LOAD(va, it + 4 * NGW); if (it + NGW <= last) CM_STORE(vb, it + NGW);
        CM_LOAD(vb, it + 5 * NGW); if (it + 2 * NGW <= last) CM_STORE(vc, it + 2 * NGW);
        CM_LOAD(vc, it + 6 * NGW); if (it + 3 * NGW <= last) CM_STORE(vd, it + 3 * NGW);
    }
#undef CM_LOAD
#undef CM_STORE
}
__device__ __forceinline__ void conv_lora96(const float* Wf, const float* Wb, bf16* WT, int gtid, int NT_) {
    for (int i = gtid; i < 4096 * 32; i += NT_) { const int n = i & 4095, k8 = i >> 12; const float* W = n < 2048 ? Wf : Wb; const int nn = n & 2047;
        v4u o = {0u, 0u, 0u, 0u};
        if (k8 < 12) { float v[8];
#pragma unroll
            for (int j = 0; j < 8; ++j) v[j] = W[(size_t)(8 * k8 + j) * 2048 + nn];
            o.x = pk2(v[0], v[1]); o.y = pk2(v[2], v[3]); o.z = pk2(v[4], v[5]); o.w = pk2(v[6], v[7]); }
        *(GAS v4u*)(WT + (size_t)n * 256 + 8 * k8) = o; }
}

template <typename Tv> __device__ __forceinline__ Tv gld(const void* base, unsigned off) { return *(const GAS Tv*)((const GAS char*)base + off); }
template <typename Tv> __device__ __forceinline__ void gst(void* base, unsigned off, Tv v) { *(GAS Tv*)((GAS char*)base + off) = v; }
__device__ __forceinline__ void row_norm_bf16(const float* xrow, const float* g, bf16* orow, LAS f32x4* rowbuf, int lane) {
    const unsigned l16 = (unsigned)lane * 16u, l8 = (unsigned)lane * 8u;
    float s = 0.f;
#pragma unroll 8
    for (int j = 0; j < 16; ++j) { const f32x4 v = gld<f32x4>(xrow, l16 + 1024u * j); rowbuf[lane + 64 * j] = v; s += dot4(v, v); }
    const float rstd = 1.0f / sqrtf(wave_sum(s) * (1.0f / D) + NORM_EPS);
#pragma unroll 8
    for (int j = 0; j < 16; ++j) { const f32x4 gg = gld<f32x4>(g, l16 + 1024u * j); const f32x4 o = rowbuf[lane + 64 * j] * rstd * gg; v2u w; w.x = pk2(o.x, o.y); w.y = pk2(o.z, o.w); gst<v2u>(orow, l8 + 512u * j, w); }
}
__device__ __forceinline__ f32x4 bf4_to_f32(v2u w) { return (f32x4){__uint_as_float(w.x << 16), __uint_as_float(w.x & 0xffff0000u), __uint_as_float(w.y << 16), __uint_as_float(w.y & 0xffff0000u)}; }
__device__ __forceinline__ v2u f32_to_bf4(f32x4 o) { v2u w; w.x = pk2(o.x, o.y); w.y = pk2(o.z, o.w); return w; }
template <bool LAST, bool BASE_F32> __device__ __forceinline__ void row_res_norm(const bf16* frow, const void* baserow, float scale, const float* ga, const float* gb, bf16* hrow, bf16* xnrow, float* outrow, LAS f32x4* rowbuf, int lane) {
    const unsigned l16 = (unsigned)lane * 16u, l8 = (unsigned)lane * 8u;
    float s = 0.f;
#pragma unroll 8
    for (int j = 0; j < 16; ++j) { const f32x4 v = bf4_to_f32(gld<v2u>(frow, l8 + 512u * j)); rowbuf[lane + 64 * j] = v; s += dot4(v, v); }
    const float rf = scale / sqrtf(wave_sum(s) * (1.0f / D) + NORM_EPS);
    float s2 = 0.f;
#pragma unroll 8
    for (int j = 0; j < 16; ++j) { const f32x4 b = BASE_F32 ? gld<f32x4>(baserow, l16 + 1024u * j) : bf4_to_f32(gld<v2u>(baserow, l8 + 512u * j)), g = gld<f32x4>(ga, l16 + 1024u * j);
        f32x4 h = b + rowbuf[lane + 64 * j] * rf * g;
        if (!LAST) { const v2u hw = f32_to_bf4(h); gst<v2u>(hrow, l8 + 512u * j, hw); h = bf4_to_f32(hw); }
        rowbuf[lane + 64 * j] = h; s2 += dot4(h, h); }
    const float rh = 1.0f / sqrtf(wave_sum(s2) * (1.0f / D) + NORM_EPS);
#pragma unroll 8
    for (int j = 0; j < 16; ++j) { const f32x4 g = gld<f32x4>(gb, l16 + 1024u * j); const f32x4 o = rowbuf[lane + 64 * j] * rh * g;
        if (LAST) gst<f32x4>(outrow, l16 + 1024u * j, o);
        else gst<v2u>(xnrow, l8 + 512u * j, f32_to_bf4(o)); }
}

__device__ __forceinline__ void unpack8(v4u w, f32x4& a, f32x4& b) { a = (f32x4){__uint_as_float(w.x << 16), __uint_as_float(w.x & 0xffff0000u), __uint_as_float(w.y << 16), __uint_as_float(w.y & 0xffff0000u)};
    b = (f32x4){__uint_as_float(w.z << 16), __uint_as_float(w.z & 0xffff0000u), __uint_as_float(w.w << 16), __uint_as_float(w.w & 0xffff0000u)}; }
__device__ __forceinline__ v4u pack8(f32x4 a, f32x4 b) { v4u w; w.x = pk2(a.x, a.y); w.y = pk2(a.z, a.w); w.z = pk2(b.x, b.y); w.w = pk2(b.z, b.w); return w; }
__device__ __forceinline__ void rr_load16(v4u (&r)[8], const bf16* row, unsigned l16) {
#pragma unroll
    for (int j = 0; j < 8; ++j) r[j] = gld<v4u>(row, l16 + 1024u * j); }
__device__ __forceinline__ void rr_loadx(f32x4 (&x)[16], const float* row, unsigned l32) {
#pragma unroll
    for (int j = 0; j < 8; ++j) { x[2 * j] = gld<f32x4>(row, l32 + 2048u * j); x[2 * j + 1] = gld<f32x4>(row, l32 + 2048u * j + 16u); } }
template <bool LAST, bool BASE_F32> __device__ __forceinline__ void rr_process(const v4u (&f)[8], const v4u (&b)[8], f32x4 (&x)[16], const float* xnext, float scale, const LAS f32x4* gal, const LAS f32x4* gbl,
                                                                               bf16* hrow, bf16* xnrow, float* outrow, int lane) {
    const unsigned l16 = (unsigned)lane * 16u, l32 = (unsigned)lane * 32u;
    float s = 0.f;
#pragma unroll
    for (int j = 0; j < 8; ++j) { f32x4 f0, f1; unpack8(f[j], f0, f1); s += dot4(f0, f0) + dot4(f1, f1); }
    const float rf = scale / sqrtf(wave_sum(s) * (1.0f / D) + NORM_EPS);
    float s2 = 0.f; v4u hb[8];
#pragma unroll
    for (int j = 0; j < 8; ++j) { f32x4 f0, f1, b0, b1; unpack8(f[j], f0, f1);
        if (BASE_F32) { b0 = x[2 * j]; b1 = x[2 * j + 1]; } else unpack8(b[j], b0, b1);
        const f32x4 g0 = gal[2 * lane + 128 * j], g1 = gal[2 * lane + 128 * j + 1];
        f32x4 h0 = b0 + f0 * rf * g0, h1 = b1 + f1 * rf * g1;
        if (!LAST) { const v4u hw = pack8(h0, h1); gst<v4u>(hrow, l16 + 1024u * j, hw); if (BASE_F32) hb[j] = hw; unpack8(hw, h0, h1); }
        s2 += dot4(h0, h0) + dot4(h1, h1); __builtin_amdgcn_sched_barrier(0); }
    if (BASE_F32) rr_loadx(x, xnext, l32);
    const float rh = 1.0f / sqrtf(wave_sum(s2) * (1.0f / D) + NORM_EPS);
#pragma unroll
    for (int j = 0; j < 8; ++j) { f32x4 h0, h1;
        if (BASE_F32) unpack8(hb[j], h0, h1);
        else { f32x4 f0, f1, b0, b1; unpack8(f[j], f0, f1); unpack8(b[j], b0, b1); const f32x4 g0 = gal[2 * lane + 128 * j], g1 = gal[2 * lane + 128 * j + 1];
            h0 = b0 + f0 * rf * g0; h1 = b1 + f1 * rf * g1; if (!LAST) unpack8(pack8(h0, h1), h0, h1); }
        const f32x4 g0 = gbl[2 * lane + 128 * j], g1 = gbl[2 * lane + 128 * j + 1];
        const f32x4 o0 = h0 * rh * g0, o1 = h1 * rh * g1;
        if (LAST) { gst<f32x4>(outrow, l32 + 2048u * j, o0); gst<f32x4>(outrow, l32 + 2048u * j + 16u, o1); }
        else gst<v4u>(xnrow, l16 + 1024u * j, pack8(o0, o1));
        __builtin_amdgcn_sched_barrier(0); }
}
template <bool LAST, bool BASE_F32> __device__ __forceinline__ void rr_phase(LAS unsigned char* ldsb, const bf16* F, const void* base, float scale, const float* ga, const float* gb, bf16* H, bf16* XNo, float* out,
                                                                             int gw, int NGW, int tid, int lane) {
    LAS f32x4* gal = (LAS f32x4*)ldsb; LAS f32x4* gbl = gal + 1024;
    __syncthreads();
    for (int i = tid; i < 1024; i += NWAVES * 64) { gal[i] = ((const GAS f32x4*)ga)[i]; gbl[i] = ((const GAS f32x4*)gb)[i]; }
    __syncthreads();
    const unsigned l16 = (unsigned)lane * 16u, l32 = (unsigned)lane * 32u;
    int m = gw; if (m >= T) return;
    v4u fA[8], fB[8], bA[8] = {}, bB[8] = {}; f32x4 x[16] = {};
    const bf16* B16 = (const bf16*)base; const float* BX = (const float*)base;
    rr_load16(fA, F + (size_t)m * D, l16);
    if (BASE_F32) rr_loadx(x, BX + (size_t)m * D, l32); else rr_load16(bA, B16 + (size_t)m * D, l16);
#pragma unroll 1
    for (; m < T; m += 2 * NGW) {
        const int m1 = m + NGW, m1c = m1 < T ? m1 : m, m2 = m + 2 * NGW, m2c = m2 < T ? m2 : m;
        rr_load16(fB, F + (size_t)m1c * D, l16); if (!BASE_F32) rr_load16(bB, B16 + (size_t)m1c * D, l16);
        rr_process<LAST, BASE_F32>(fA, bA, x, BX + (size_t)m1c * D, scale, gal, gbl, H + (size_t)m * D, XNo + (size_t)m * D, out + (size_t)m * D, lane);
        rr_load16(fA, F + (size_t)m2c * D, l16); if (!BASE_F32) rr_load16(bA, B16 + (size_t)m2c * D, l16);
        if (m1 < T) rr_process<LAST, BASE_F32>(fB, bB, x, BX + (size_t)m2c * D, scale, gal, gbl, H + (size_t)m1 * D, XNo + (size_t)m1 * D, out + (size_t)m1 * D, lane);
    }
}

__device__ __forceinline__ void xn_process(const f32x4 (&x)[16], const LAS f32x4* gl, bf16* orow, int lane) {
    float s = 0.f;
#pragma unroll
    for (int j = 0; j < 16; ++j) s += dot4(x[j], x[j]);
    const float rstd = 1.0f / sqrtf(wave_sum(s) * (1.0f / D) + NORM_EPS);
#pragma unroll
    for (int j = 0; j < 8; ++j) { const f32x4 o0 = x[2 * j] * rstd * gl[2 * lane + 128 * j], o1 = x[2 * j + 1] * rstd * gl[2 * lane + 128 * j + 1];
        gst<v4u>(orow, (unsigned)lane * 16u + 1024u * j, pack8(o0, o1)); __builtin_amdgcn_sched_barrier(0); }
}
__device__ __forceinline__ void xn_phase(LAS unsigned char* ldsb, const float* X, const float* g, bf16* XNo, int gw, int NGW, int tid, int lane) {
    LAS f32x4* gl = (LAS f32x4*)ldsb;
    __syncthreads();
    for (int i = tid; i < 1024; i += NWAVES * 64) gl[i] = ((const GAS f32x4*)g)[i];
    __syncthreads();
    const unsigned l32 = (unsigned)lane * 32u; int m = gw; if (m >= T) return;
    f32x4 xa[16], xb[16]; rr_loadx(xa, X + (size_t)m * D, l32);
#pragma unroll 1
    for (; m < T; m += 2 * NGW) { const int m1 = m + NGW, m1c = m1 < T ? m1 : m, m2 = m + 2 * NGW, m2c = m2 < T ? m2 : m;
        rr_loadx(xb, X + (size_t)m1c * D, l32); xn_process(xa, gl, XNo + (size_t)m * D, lane);
        rr_loadx(xa, X + (size_t)m2c * D, l32); if (m1 < T) xn_process(xb, gl, XNo + (size_t)m1 * D, lane); }
}

struct PrepA { const bf16* PR; const float* mu_prev; const float* mu_next; const float* k_k; bf16* R; bf16* K; bf16* V; bf16* KK; bf16* HW; bf16* XA; bf16* SG; };
__device__ __forceinline__ void prep_a_row(const PrepA& P, int t, int lane) {
    const bf16* cur = P.PR + (size_t)t * RCP; const bool hp = t > 0, hn = t < T - 1;
    const bf16* prv = cur - RCP; const bf16* nxt = cur + RCP;
#pragma unroll 2
    for (int j = 0; j < 26; ++j) {
        const int c0 = 4 * lane + 256 * j;
        if (c0 < RC) {
            const f32x4 c = bf4_to_f32(*(const GAS v2u*)(cur + c0));
            const f32x4 pv = hp ? bf4_to_f32(*(const GAS v2u*)(prv + c0)) : (f32x4){0.f, 0.f, 0.f, 0.f};
            const f32x4 nv = hn ? bf4_to_f32(*(const GAS v2u*)(nxt + c0)) : (f32x4){0.f, 0.f, 0.f, 0.f};
            const f32x4 mp = *(const GAS f32x4*)(P.mu_prev + c0), mn = *(const GAS f32x4*)(P.mu_next + c0);
            const f32x4 p = c + mp * (pv - c) + mn * (nv - c);
            if (j < 8) { *(GAS v2u*)(P.R + (size_t)t * DR + c0) = f32_to_bf4(p); }
            else if (j < 16) { const int cc = c0 - 2048; *(GAS v2u*)(P.K + (size_t)t * DR + cc) = f32_to_bf4(p);
                const f32x4 kv = p * *(const GAS f32x4*)(P.k_k + cc); const float ss = row16_sum(dot4(kv, kv));
                const float inv = 1.0f / fmaxf(sqrtf(ss), 1e-12f); *(GAS v2u*)(P.KK + (size_t)t * DR + cc) = f32_to_bf4(kv * inv); }
            else if (j < 24) { *(GAS v2u*)(P.V + (size_t)t * DR + (c0 - 4096)) = f32_to_bf4(p); }
            else if (c0 < 6240) { v2u w; w.x = pk2(tanhf(p.x), tanhf(p.y)); w.y = pk2(tanhf(p.z), tanhf(p.w)); *(GAS v2u*)(P.HW + (size_t)t * LK + (c0 - 6144)) = w; }
            else if (c0 < 6336) { v2u w; w.x = pk2(p.x, p.y); w.y = pk2(p.z, p.w); *(GAS v2u*)(P.XA + (size_t)t * LK + (c0 - 6240)) = w; }
            else { v2u w; w.x = pk2(sigm(p.x), sigm(p.y)); w.y = pk2(sigm(p.z), sigm(p.w)); *(GAS v2u*)(P.SG + (size_t)t * LK + (c0 - 6336)) = w; }
        }
    }
    if (lane < 40) { const v2u z = {0u, 0u}; *(GAS v2u*)(P.HW + (size_t)t * LK + 96 + 4 * lane) = z; *(GAS v2u*)(P.XA + (size_t)t * LK + 96 + 4 * lane) = z; }
}

__device__ __forceinline__ float sum8_lanes(float x) {
    x += __int_as_float(__builtin_amdgcn_update_dpp(0, __float_as_int(x), 0xB1, 0xf, 0xf, false));
    x += __int_as_float(__builtin_amdgcn_update_dpp(0, __float_as_int(x), 0x4E, 0xf, 0xf, false));
    x += __int_as_float(__builtin_amdgcn_update_dpp(0, __float_as_int(x), 0x141, 0xf, 0xf, false));
    return x; }
template <int NJ> struct PrepSet { v4u c[NJ], p[NJ], n[NJ]; };
template <int J0, int NJ> __device__ __forceinline__ void prep_load(PrepSet<4>& S, const bf16* cur, const bf16* prv, const bf16* nxt, unsigned l16) {
#pragma unroll
    for (int jj = 0; jj < NJ; ++jj) { const unsigned off = l16 + 1024u * (J0 + jj); S.c[jj] = gld<v4u>(cur, off); S.p[jj] = gld<v4u>(prv, off); S.n[jj] = gld<v4u>(nxt, off); } }
template <int J> __device__ __forceinline__ void prep_shift(const PrepSet<4>& S, int jj, bool hp, bool hn, const LAS f32x4* mup, const LAS f32x4* mun, int lane, f32x4& r0, f32x4& r1) {
    f32x4 c0, c1, p0, p1, n0, n1; unpack8(S.c[jj], c0, c1); unpack8(S.p[jj], p0, p1); unpack8(S.n[jj], n0, n1);
    const f32x4 z = {0.f, 0.f, 0.f, 0.f}; if (!hp) { p0 = z; p1 = z; } if (!hn) { n0 = z; n1 = z; }
    const f32x4 a0 = mup[2 * lane + 128 * J], a1 = mup[2 * lane + 128 * J + 1], b0 = mun[2 * lane + 128 * J], b1 = mun[2 * lane + 128 * J + 1];
    r0 = c0 + a0 * (p0 - c0) + b0 * (n0 - c0); r1 = c1 + a1 * (p1 - c1) + b1 * (n1 - c1); }
template <int J0> __device__ __forceinline__ void prep_store4(const PrepSet<4>& S, bool hp, bool hn, const LAS f32x4* mup, const LAS f32x4* mun, bf16* dst, int lane) {
#pragma unroll
    for (int jj = 0; jj < 4; ++jj) { f32x4 r0, r1;
        switch (jj) { case 0: prep_shift<J0 + 0>(S, 0, hp, hn, mup, mun, lane, r0, r1); break; case 1: prep_shift<J0 + 1>(S, 1, hp, hn, mup, mun, lane, r0, r1); break;
                      case 2: prep_shift<J0 + 2>(S, 2, hp, hn, mup, mun, lane, r0, r1); break; default: prep_shift<J0 + 3>(S, 3, hp, hn, mup, mun, lane, r0, r1); break; }
        gst<v4u>(dst, (unsigned)lane * 16u + 1024u * jj, pack8(r0, r1)); __builtin_amdgcn_sched_barrier(0); } }
__device__ __forceinline__ void prep_store_k(const PrepSet<4>& S, bool hp, bool hn, const LAS f32x4* mup, const LAS f32x4* mun, const LAS f32x4* kk4, bf16* dstK, bf16* dstKK, int lane) {
#pragma unroll
    for (int jj = 0; jj < 4; ++jj) { f32x4 r0, r1;
        switch (jj) { case 0: prep_shift<4>(S, 0, hp, hn, mup, mun, lane, r0, r1); break; case 1: prep_shift<5>(S, 1, hp, hn, mup, mun, lane, r0, r1); break;
                      case 2: prep_shift<6>(S, 2, hp, hn, mup, mun, lane, r0, r1); break; default: prep_shift<7>(S, 3, hp, hn, mup, mun, lane, r0, r1); break; }
        gst<v4u>(dstK, (unsigned)lane * 16u + 1024u * jj, pack8(r0, r1));
        const f32x4 k0 = r0 * kk4[2 * lane + 128 * jj], k1 = r1 * kk4[2 * lane + 128 * jj + 1]; const float ss = sum8_lanes(dot4(k0, k0) + dot4(k1, k1));
        const float inv = 1.0f / fmaxf(sqrtf(ss), 1e-12f); gst<v4u>(dstKK, (unsigned)lane * 16u + 1024u * jj, pack8(k0 * inv, k1 * inv)); __builtin_amdgcn_sched_barrier(0); } }
__device__ __forceinline__ void prep_store_l(const PrepSet<4>& S, bool hp, bool hn, const LAS f32x4* mup, const LAS f32x4* mun, bf16* hw, bf16* xa, bf16* sg, int lane) {
    f32x4 r0, r1; prep_shift<12>(S, 0, hp, hn, mup, mun, lane, r0, r1);
    if (lane < 12) { const f32x4 t0 = {tanhf(r0.x), tanhf(r0.y), tanhf(r0.z), tanhf(r0.w)}, t1 = {tanhf(r1.x), tanhf(r1.y), tanhf(r1.z), tanhf(r1.w)}; gst<v4u>(hw, (unsigned)lane * 16u, pack8(t0, t1)); }
    else if (lane < 24) gst<v4u>(xa, (unsigned)(lane - 12) * 16u, pack8(r0, r1));
    else if (lane < 56) { const f32x4 t0 = {sigm(r0.x), sigm(r0.y), sigm(r0.z), sigm(r0.w)}, t1 = {sigm(r1.x), sigm(r1.y), sigm(r1.z), sigm(r1.w)}; gst<v4u>(sg, (unsigned)(lane - 24) * 16u, pack8(t0, t1)); }
    if (lane < 20) { const v4u z = {0u, 0u, 0u, 0u}; gst<v4u>(hw, 192u + (unsigned)lane * 16u, z); gst<v4u>(xa, 192u + (unsigned)lane * 16u, z); }
}
__device__ __forceinline__ void prep_phase(LAS unsigned char* ldsb, const PrepA& P, int gw, int NGW, int tid, int lane) {
    LAS f32x4* mup = (LAS f32x4*)ldsb; LAS f32x4* mun = mup + 1664; LAS f32x4* kk4 = mun + 1664;
    __syncthreads();
    for (int i = tid; i < RC / 4; i += NWAVES * 64) { mup[i] = ((const GAS f32x4*)P.mu_prev)[i]; mun[i] = ((const GAS f32x4*)P.mu_next)[i]; }
    for (int i = tid; i < DR / 4; i += NWAVES * 64) kk4[i] = ((const GAS f32x4*)P.k_k)[i];
    __syncthreads();
    const unsigned l16 = (unsigned)lane * 16u;
    int t = gw; if (t >= T) return;
    PrepSet<4> A, B;
#define PREP_ROWS(tt) const bf16* cur_ = P.PR + (size_t)(tt) * RCP; const bf16* prv_ = (tt) > 0 ? cur_ - RCP : cur_; const bf16* nxt_ = (tt) < T - 1 ? cur_ + RCP : cur_
    { PREP_ROWS(t); prep_load<0, 4>(A, cur_, prv_, nxt_, l16); }
#pragma unroll 1
    for (; t < T; t += NGW) {
        const bool hp = t > 0, hn = t < T - 1; const int tn = t + NGW < T ? t + NGW : t;
        PREP_ROWS(t);
        prep_load<4, 4>(B, cur_, prv_, nxt_, l16);  prep_store4<0>(A, hp, hn, mup, mun, P.R + (size_t)t * DR, lane);
        prep_load<8, 4>(A, cur_, prv_, nxt_, l16);  prep_store_k(B, hp, hn, mup, mun, kk4, P.K + (size_t)t * DR, P.KK + (size_t)t * DR, lane);
        prep_load<12, 1>(B, cur_, prv_, nxt_, l16); prep_store4<8>(A, hp, hn, mup, mun, P.V + (size_t)t * DR, lane);
        { const bf16* c2 = P.PR + (size_t)tn * RCP; const bf16* p2 = tn > 0 ? c2 - RCP : c2; const bf16* n2 = tn < T - 1 ? c2 + RCP : c2; prep_load<0, 4>(A, c2, p2, n2, l16); }
        prep_store_l(B, hp, hn, mup, mun, P.HW + (size_t)t * LK, P.XA + (size_t)t * LK, P.SG + (size_t)t * LK, lane);
    }
#undef PREP_ROWS
}

__device__ __forceinline__ void qk_norm_row(const bf16* qkvrow, float (&mx)[8], int lane) {
#pragma unroll
    for (int j = 0; j < 8; ++j) { const v4u w = *(const GAS v4u*)(qkvrow + 8 * lane + 512 * j); float ss = 0.f;
#pragma unroll
        for (int e = 0; e < 4; ++e) { const float lo = __uint_as_float(w[e] << 16), hi = __uint_as_float(w[e] & 0xffff0000u); ss += lo * lo + hi * hi; }
        ss += __shfl_xor(ss, 1); ss += __shfl_xor(ss, 2); ss += __shfl_xor(ss, 4);
        mx[j] = fmaxf(mx[j], ss); }
}

__device__ __forceinline__ void qk_load(v4u (&w)[8], const bf16* qkvrow, unsigned l16) {
#pragma unroll
    for (int j = 0; j < 8; ++j) w[j] = gld<v4u>(qkvrow, l16 + 1024u * j); }
__device__ __forceinline__ void qk_acc(const v4u (&w)[8], float (&mx)[8]) {
#pragma unroll
    for (int j = 0; j < 8; ++j) { float ss = 0.f;
#pragma unroll
        for (int e = 0; e < 4; ++e) { const float lo = __uint_as_float(w[j][e] << 16), hi = __uint_as_float(w[j][e] & 0xffff0000u); ss += lo * lo + hi * hi; }
        mx[j] = fmaxf(mx[j], sum8_lanes(ss)); } }
__device__ __forceinline__ void qk_norm_rows(const bf16* QKV, float (&mx)[8], int gw, int NGW, int lane) {
    const unsigned l16 = (unsigned)lane * 16u; int t = gw; if (t >= T) return;
    v4u a[8], b[8]; qk_load(a, QKV + (size_t)t * QKVW, l16);
#pragma unroll 1
    for (; t < T; t += 2 * NGW) { const int t1 = t + NGW < T ? t + NGW : t, t2 = t + 2 * NGW < T ? t + 2 * NGW : t;
        qk_load(b, QKV + (size_t)t1 * QKVW, l16); qk_acc(a, mx); qk_load(a, QKV + (size_t)t2 * QKVW, l16); qk_acc(b, mx); }
}

struct PostR { const float* YF; const float* YB; const bf16* V; const float* BF; const float* BB; const bf16* G; const float* gn_w; const float* gn_b; bf16* MIX; };
__device__ __forceinline__ void post_r_row(const PostR& P, int t, int lane) {
    const size_t ro = (size_t)t * DR;
#pragma unroll 2
    for (int j = 0; j < 8; ++j) {
        const int c0 = 4 * lane + 256 * j; const size_t o = ro + c0; const int hd = (lane >> 4) + 4 * j;
        const f32x4 y = *(const GAS f32x4*)(P.YF + o) + *(const GAS f32x4*)(P.YB + o);
        const float mean = row16_sum(sum4(y)) * (1.0f / 64.0f); const f32x4 d = y - mean;
        const float var = row16_sum(dot4(d, d)) * (1.0f / 64.0f); const float rs = 1.0f / sqrtf(var + GN_EPS);
        const f32x4 yn = d * rs * *(const GAS f32x4*)(P.gn_w + c0) + *(const GAS f32x4*)(P.gn_b + c0);
        const f32x4 v = bf4_to_f32(*(const GAS v2u*)(P.V + o)), g = bf4_to_f32(*(const GAS v2u*)(P.G + o));
        const float bs = ((const GAS float*)P.BF)[(size_t)t * NHR + hd] + ((const GAS float*)P.BB)[(size_t)t * NHR + hd];
        const f32x4 out = (yn + bs * v) * g;
        v2u w; w.x = pk2(out.x, out.y); w.y = pk2(out.z, out.w); *(GAS v2u*)(P.MIX + (size_t)t * D + c0) = w;
    }
}

namespace att {
typedef short s16x4 __attribute__((ext_vector_type(4)));
typedef float f32x16 __attribute__((ext_vector_type(16)));
constexpr int KVBLK = 64, LDK = QKVW;
constexpr int SHM_V = 16384, SHM_K = 8192, V_OFF = 0, K_OFF = 2 * SHM_V, WS_OFF = K_OFF + 2 * SHM_K;
constexpr float THR2 = 11.5f;
#define KSWZ64(row, colB) ((row) * 128 + ((colB) ^ ((((row) >> 1) & 7) << 4)))
#define SBAR() __builtin_amdgcn_sched_barrier(0)
__device__ __forceinline__ int crow(int r, int hi) { return (r & 3) + 8 * (r >> 2) + 4 * hi; }
__device__ __forceinline__ void partialSM(f32x16& p0, f32x16& p1, float& m_reg, float& mn, float& alpha, float tq, float nsl2) {
#ifndef ATT_NOBIAS
#pragma unroll
  for (int r = 0; r < 16; ++r) { const float d0 = tq + (float)((r & 3) + 8 * (r >> 2)); p0[r] = fmaf(fabsf(d0), nsl2, p0[r]); }
#pragma unroll
  for (int r = 0; r < 16; ++r) { const float d1 = tq + (float)(32 + (r & 3) + 8 * (r >> 2)); p1[r] = fmaf(fabsf(d1), nsl2, p1[r]); }
#endif
  float pmax = p0[0];
#pragma unroll
  for (int r = 1; r < 16; ++r) pmax = fmaxf(pmax, p0[r]);
#pragma unroll
  for (int r = 0; r < 16; ++r) pmax = fmaxf(pmax, p1[r]);
  { auto rr = __builtin_amdgcn_permlane32_swap(__float_as_uint(pmax), __float_as_uint(pmax), false, false);
    pmax = fmaxf(__uint_as_float(rr[0]), __uint_as_float(rr[1])); }
  if (__builtin_expect(__all(pmax - m_reg <= THR2), 1)) { mn = m_reg; alpha = 1.f; }
  else { mn = fmaxf(m_reg, pmax); alpha = __builtin_amdgcn_exp2f(m_reg - mn); m_reg = mn; }
#pragma unroll
  for (int r = 0; r < 16; ++r) p0[r] = __builtin_amdgcn_exp2f(p0[r] - mn);
#pragma unroll
  for (int r = 0; r < 16; ++r) p1[r] = p1[r] - mn;
}
__device__ __forceinline__ void finishSM(f32x16& p0, f32x16& p1, float alpha, float& l_reg, bf16x8& pa0, bf16x8& pa1, bf16x8& pa2, bf16x8& pa3) {
#pragma unroll
  for (int r = 0; r < 16; ++r) p1[r] = __builtin_amdgcn_exp2f(p1[r]);
  float ps = 0;
#pragma unroll
  for (int r = 0; r < 16; ++r) ps += p0[r];
#pragma unroll
  for (int r = 0; r < 16; ++r) ps += p1[r];
  { auto rr = __builtin_amdgcn_permlane32_swap(__float_as_uint(ps), __float_as_uint(ps), false, false);
    ps = __uint_as_float(rr[0]) + __uint_as_float(rr[1]); }
  l_reg = l_reg * alpha + ps;
#define PK4(P, BASE, OUT) do { unsigned a0 = pk2(P[BASE + 0], P[BASE + 1]), a1 = pk2(P[BASE + 2], P[BASE + 3]);   \
    unsigned b0 = pk2(P[BASE + 4], P[BASE + 5]), b1 = pk2(P[BASE + 6], P[BASE + 7]);                              \
    auto r0 = __builtin_amdgcn_permlane32_swap(a0, b0, false, false); auto r1 = __builtin_amdgcn_permlane32_swap(a1, b1, false, false); \
    v4u w = {r0[0], r1[0], r0[1], r1[1]}; OUT = *reinterpret_cast<bf16x8*>(&w); } while (0)
  PK4(p0, 0, pa0); PK4(p0, 8, pa1); PK4(p1, 0, pa2); PK4(p1, 8, pa3);
#undef PK4
}
__device__ __forceinline__ void qkt(f32x16& p0, f32x16& p1, const LAS unsigned char* Ks, const bf16x8* qr, int r32, int hi) {
  p0 = f32x16{}; p1 = f32x16{};
#pragma unroll
  for (int d0 = 0; d0 < 4; ++d0) { const int cb = d0 * 32 + hi * 16;
    const bf16x8 b0 = *reinterpret_cast<const LAS bf16x8*>(Ks + KSWZ64(r32, cb));
    const bf16x8 b1 = *reinterpret_cast<const LAS bf16x8*>(Ks + KSWZ64(32 + r32, cb));
    p0 = __builtin_amdgcn_mfma_f32_32x32x16_bf16(b0, qr[d0], p0, 0, 0, 0);
    p1 = __builtin_amdgcn_mfma_f32_32x32x16_bf16(b1, qr[d0], p1, 0, 0, 0); }
}
__device__ __forceinline__ int v_st(int k, int c) { const int kk = (k & ~0xC) | ((k & 4) << 1) | ((k & 8) >> 1); return ((kk >> 3) * 4 + (c >> 5)) * 512 + ((kk & 7) * 32 + (c & 31)) * 2; }
__device__ __forceinline__ int v_rd_base(int lane) { return ((lane & 3) << 3) | (((lane >> 2) & 3) << 6) | (((lane >> 4) & 1) << 5) | (((lane >> 5) & 1) << 8); }
constexpr int v_rd_off(int d0, int ks, int half) { return d0 * 512 + ks * 4096 + half * 2048; }
template <int OFF> __device__ __forceinline__ s16x4 tr_read(int vb) {
  s16x4 r; asm volatile("ds_read_b64_tr_b16 %0, %1 offset:%2" : "=&v"(r) : "v"(vb), "i"(OFF) : "memory"); return r;
}
template <int D0> __device__ __forceinline__ void pv_one(f32x16& od, int vb, bf16x8 pa0, bf16x8 pa1, bf16x8 pa2, bf16x8 pa3) {
  const s16x4 l0 = tr_read<v_rd_off(D0, 0, 0)>(vb), h0 = tr_read<v_rd_off(D0, 0, 1)>(vb), l1 = tr_read<v_rd_off(D0, 1, 0)>(vb), h1 = tr_read<v_rd_off(D0, 1, 1)>(vb);
  const s16x4 l2 = tr_read<v_rd_off(D0, 2, 0)>(vb), h2 = tr_read<v_rd_off(D0, 2, 1)>(vb), l3 = tr_read<v_rd_off(D0, 3, 0)>(vb), h3 = tr_read<v_rd_off(D0, 3, 1)>(vb);
  asm volatile("s_waitcnt lgkmcnt(0)" ::: "memory"); SBAR();
#define PKV(L, H) (bf16x8){L[0], L[1], L[2], L[3], H[0], H[1], H[2], H[3]}
  od = __builtin_amdgcn_mfma_f32_32x32x16_bf16(pa0, PKV(l0, h0), od, 0, 0, 0);
  od = __builtin_amdgcn_mfma_f32_32x32x16_bf16(pa1, PKV(l1, h1), od, 0, 0, 0);
  od = __builtin_amdgcn_mfma_f32_32x32x16_bf16(pa2, PKV(l2, h2), od, 0, 0, 0);
  od = __builtin_amdgcn_mfma_f32_32x32x16_bf16(pa3, PKV(l3, h3), od, 0, 0, 0);
#undef PKV
}
#define PKV(L, H) (bf16x8){L[0], L[1], L[2], L[3], H[0], H[1], H[2], H[3]}
template <int D0> __device__ __forceinline__ void pv_rd(s16x4 (&v)[8], int vb) {
  v[0] = tr_read<v_rd_off(D0, 0, 0)>(vb); v[1] = tr_read<v_rd_off(D0, 0, 1)>(vb); v[2] = tr_read<v_rd_off(D0, 1, 0)>(vb); v[3] = tr_read<v_rd_off(D0, 1, 1)>(vb);
  v[4] = tr_read<v_rd_off(D0, 2, 0)>(vb); v[5] = tr_read<v_rd_off(D0, 2, 1)>(vb); v[6] = tr_read<v_rd_off(D0, 3, 0)>(vb); v[7] = tr_read<v_rd_off(D0, 3, 1)>(vb);
}
__device__ __forceinline__ void pv_mm(f32x16& od, const s16x4 (&v)[8], bf16x8 pa0, bf16x8 pa1, bf16x8 pa2, bf16x8 pa3) {
  od = __builtin_amdgcn_mfma_f32_32x32x16_bf16(pa0, PKV(v[0], v[1]), od, 0, 0, 0);
  od = __builtin_amdgcn_mfma_f32_32x32x16_bf16(pa1, PKV(v[2], v[3]), od, 0, 0, 0);
  od = __builtin_amdgcn_mfma_f32_32x32x16_bf16(pa2, PKV(v[4], v[5]), od, 0, 0, 0);
  od = __builtin_amdgcn_mfma_f32_32x32x16_bf16(pa3, PKV(v[6], v[7]), od, 0, 0, 0);
}
__device__ __forceinline__ void pv_d0(f32x16* o, int vb, bf16x8 pa0, bf16x8 pa1, bf16x8 pa2, bf16x8 pa3) {
  s16x4 va[8], vb_[8];
  pv_rd<0>(va, vb); pv_rd<1>(vb_, vb);
  asm volatile("s_waitcnt lgkmcnt(8)" ::: "memory"); SBAR(); pv_mm(o[0], va, pa0, pa1, pa2, pa3); SBAR();
  pv_rd<2>(va, vb);
  asm volatile("s_waitcnt lgkmcnt(8)" ::: "memory"); SBAR(); pv_mm(o[1], vb_, pa0, pa1, pa2, pa3); SBAR();
  pv_rd<3>(vb_, vb);
  asm volatile("s_waitcnt lgkmcnt(8)" ::: "memory"); SBAR(); pv_mm(o[2], va, pa0, pa1, pa2, pa3); SBAR();
  asm volatile("s_waitcnt lgkmcnt(0)" ::: "memory"); SBAR(); pv_mm(o[3], vb_, pa0, pa1, pa2, pa3);
}
#undef PKV

template <int c> __device__ __forceinline__ void map_epilogue(f32x16 (&o)[4], float l_reg, LAS float* li_l, float* stash, bf16* __restrict__ MIX, const float* __restrict__ subln_g, float lam,
                                                              int h, int i0, int tid, int wid, int r32, int hi) {
    if (hi == 0) li_l[r32] = l_reg; asm volatile("s_waitcnt lgkmcnt(0)" ::: "memory");
    float rli[16];
#pragma unroll
    for (int r = 0; r < 16; ++r) rli[r] = __builtin_amdgcn_rcpf(li_l[crow(r, hi)]);
    if (c == 0) {
#pragma unroll
      for (int d0 = 0; d0 < 4; ++d0)
#pragma unroll
        for (int r = 0; r < 16; ++r) ((GAS float*)stash)[(size_t)(d0 * 16 + r) * 512 + tid] = o[d0][r] * rli[r];
    } else {
#ifndef ATT_NOEPI
      float ssq[16];
#pragma unroll
      for (int r = 0; r < 16; ++r) { float s = 0.f;
#pragma unroll
        for (int d0 = 0; d0 < 4; ++d0) { const float v = __hip_atomic_load((GAS float*)stash + (size_t)(d0 * 16 + r) * 512 + tid, __ATOMIC_RELAXED, __HIP_MEMORY_SCOPE_AGENT) - lam * (o[d0][r] * rli[r]); o[d0][r] = v; s += v * v; }
        ssq[r] = s; }
#pragma unroll
      for (int r = 0; r < 16; ++r) {
#pragma unroll
        for (int x = 1; x < 32; x <<= 1) ssq[r] += __shfl_xor(ssq[r], x); }
      float sg[4];
#pragma unroll
      for (int d0 = 0; d0 < 4; ++d0) sg[d0] = ((const GAS float*)subln_g)[32 * d0 + r32] * (1.0f - LAM_INIT);
#pragma unroll
      for (int r = 0; r < 16; ++r) { const float rs = 1.0f / sqrtf(ssq[r] * (1.0f / 128.0f) + SUBLN_EPS);
        GAS bf16* orow = (GAS bf16*)MIX + (size_t)(i0 + wid * 32 + crow(r, hi)) * D + 2048 + h * 128 + r32;
#pragma unroll
        for (int d0 = 0; d0 < 4; ++d0) orow[32 * d0] = (bf16)(pk2(o[d0][r] * rs * sg[d0], 0.f) & 0xffffu); }
#endif
    }
}

template <int c> __device__ __forceinline__ void attn_map(LAS unsigned char* lds, const bf16* __restrict__ QKV, float* stash, bf16* __restrict__ MIX, const float* __restrict__ subln_g,
                                          int h, int i0, float lam, float sl2, int W) {
  int tid_ = threadIdx.x; asm volatile("" : "+v"(tid_));
  asm volatile("" : "+s"(QKV), "+s"(stash), "+s"(MIX), "+s"(subln_g), "+s"(h), "+s"(i0), "+s"(W));
  const int tid = tid_, wid = tid >> 6, lane = tid & 63, r32 = lane & 31, hi = lane >> 5;
  LAS unsigned char* V_lds = lds + V_OFF; LAS unsigned char* K_lds = lds + K_OFF;
  LAS float* ws = (LAS float*)(lds + WS_OFF) + wid * 64; LAS float* li_l = ws; LAS float* al_l = ws + 32;
  const int sr = tid >> 4, sc = (tid & 15) * 8, vst0 = v_st(sr, sc), vst1 = v_st(32 + sr, sc);
  const int kr = tid >> 3, kc = (tid & 7) * 8, kst = KSWZ64(kr, kc * 2);
  const int vb0 = (int)(unsigned)(uintptr_t)V_lds + v_rd_base(lane);
  const int qi = i0 + wid * 32 + r32; const float nsl2 = -sl2;
  int jlo = (i0 - W > 0 ? i0 - W : 0) >> 6, jhi = (i0 + 255 + W < T - 1 ? i0 + 255 + W : T - 1) >> 6;
  if (((jhi - jlo + 1) & 1) != 0) { if (jhi < T / KVBLK - 1) ++jhi; else --jlo; }
  const int NT = jhi - jlo + 1;
  {
    const bf16* Kh = QKV + 2048 + h * 128 + c * 64; const bf16* Vh = QKV + 4096 + h * 128;
    float m_reg = -1e30f, l_reg = 0; f32x16 o[4] = {}; bf16x8 qr[4];
    { const bf16* Qw = QKV + (size_t)qi * LDK + h * 128 + c * 64 + hi * 8;
#pragma unroll
      for (int d0 = 0; d0 < 4; ++d0) qr[d0] = *(const GAS bf16x8*)(Qw + d0 * 16); }
    struct { bf16x8 vs0, vs1, ks0; } sr_[2];
#define SLOAD(i, k0) do { sr_[i].vs0 = *(const GAS bf16x8*)(&Vh[(size_t)((k0) + sr) * LDK + sc]); sr_[i].vs1 = *(const GAS bf16x8*)(&Vh[(size_t)((k0) + 32 + sr) * LDK + sc]); \
    sr_[i].ks0 = *(const GAS bf16x8*)(&Kh[(size_t)((k0) + kr) * LDK + kc]); } while (0)
#define SWRITE(b, i) do { *(LAS bf16x8*)(V_lds + (b) * SHM_V + vst0) = sr_[i].vs0; *(LAS bf16x8*)(V_lds + (b) * SHM_V + vst1) = sr_[i].vs1; \
    *(LAS bf16x8*)(K_lds + (b) * SHM_K + kst) = sr_[i].ks0; } while (0)
#define SWAIT() asm volatile("s_waitcnt vmcnt(3)" ::: "memory")
#define RESC(a) do { if (__any((a) < 1.f)) { if (hi == 0) al_l[r32] = (a); asm volatile("s_waitcnt lgkmcnt(0)" ::: "memory"); \
    _Pragma("unroll") for (int d = 0; d < 4; ++d) _Pragma("unroll") for (int r = 0; r < 16; ++r) o[d][r] *= al_l[crow(r, hi)]; } } while (0)
#define TQ(tile) ((float)((jlo + (tile)) * KVBLK + 4 * hi - qi))
#define KOFF(tile) ((jlo + (tile)) * KVBLK)
    f32x16 pA0, pA1, pB0, pB1; float mnA, mnB, alA, alB; bf16x8 pa0, pa1, pa2, pa3;
    __syncthreads();
    SLOAD(0, KOFF(0)); asm volatile("s_waitcnt vmcnt(0)" ::: "memory"); SWRITE(0, 0); __syncthreads();
    qkt(pA0, pA1, K_lds, qr, r32, hi); partialSM(pA0, pA1, m_reg, mnA, alA, TQ(0), nsl2);
    SLOAD(1, KOFF(1)); SLOAD(0, KOFF(2));
    SWAIT(); SWRITE(1, 1); __syncthreads();
#pragma unroll 1
    for (int j = 1; j + 1 < NT; j += 2) {
      SBAR(); qkt(pB0, pB1, K_lds + SHM_K, qr, r32, hi);
      finishSM(pA0, pA1, alA, l_reg, pa0, pa1, pa2, pa3); SBAR();
      SLOAD(1, KOFF(j + 2)); SBAR();
      pv_d0(o, vb0, pa0, pa1, pa2, pa3); partialSM(pB0, pB1, m_reg, mnB, alB, TQ(j), nsl2);
      __syncthreads(); SWAIT(); SWRITE(0, 0);
      RESC(alB); __syncthreads();
      SBAR(); qkt(pA0, pA1, K_lds, qr, r32, hi);
      finishSM(pB0, pB1, alB, l_reg, pa0, pa1, pa2, pa3); SBAR();
      if (j + 3 < NT) SLOAD(0, KOFF(j + 3)); SBAR();
      pv_d0(o, vb0 + SHM_V, pa0, pa1, pa2, pa3); partialSM(pA0, pA1, m_reg, mnA, alA, TQ(j + 1), nsl2);
      __syncthreads(); SWAIT(); SWRITE(1, 1);
      RESC(alA); __syncthreads();
    }
    SBAR(); qkt(pB0, pB1, K_lds + SHM_K, qr, r32, hi);
    finishSM(pA0, pA1, alA, l_reg, pa0, pa1, pa2, pa3); SBAR();
    pv_d0(o, vb0, pa0, pa1, pa2, pa3); partialSM(pB0, pB1, m_reg, mnB, alB, TQ(NT - 1), nsl2);
    __syncthreads(); RESC(alB);
    finishSM(pB0, pB1, alB, l_reg, pa0, pa1, pa2, pa3); SBAR();
    pv_d0(o, vb0 + SHM_V, pa0, pa1, pa2, pa3);
    map_epilogue<c>(o, l_reg, li_l, stash, MIX, subln_g, lam, h, i0, tid, wid, r32, hi);
#undef SLOAD
#undef SWRITE
#undef SWAIT
#undef RESC
#undef TQ
#undef KOFF
  }
}
__device__ __forceinline__ unsigned bfbits(float x) { return pk2(x, 0.f) & 0xffffu; }
__device__ __forceinline__ void qkt_fast(f32x16& p0, f32x16& p1, const LAS unsigned char* Ks, const bf16x8* qr, int r32, int hi, bool aug, v4u ka0, v4u ka1, v4u qa) {
  p0 = f32x16{}; p1 = f32x16{};
#pragma unroll
  for (int d0 = 0; d0 < 4; ++d0) { const int cb = d0 * 32 + hi * 16;
    const bf16x8 b0 = *reinterpret_cast<const LAS bf16x8*>(Ks + KSWZ64(r32, cb));
    const bf16x8 b1 = *reinterpret_cast<const LAS bf16x8*>(Ks + KSWZ64(32 + r32, cb));
    p0 = __builtin_amdgcn_mfma_f32_32x32x16_bf16(b0, qr[d0], p0, 0, 0, 0);
    p1 = __builtin_amdgcn_mfma_f32_32x32x16_bf16(b1, qr[d0], p1, 0, 0, 0); }
  if (aug) {
    p0 = __builtin_amdgcn_mfma_f32_32x32x16_bf16(*reinterpret_cast<bf16x8*>(&ka0), *reinterpret_cast<bf16x8*>(&qa), p0, 0, 0, 0);
    p1 = __builtin_amdgcn_mfma_f32_32x32x16_bf16(*reinterpret_cast<bf16x8*>(&ka1), *reinterpret_cast<bf16x8*>(&qa), p1, 0, 0, 0); }
}
__device__ __forceinline__ void partialSM_fast(f32x16& p0, f32x16& p1, bool mixed, float tq, float nsl2, float nBref) {
  if (mixed) {
#pragma unroll
    for (int r = 0; r < 16; ++r) { const float d0 = tq + (float)((r & 3) + 8 * (r >> 2)); p0[r] = fmaf(fabsf(d0), nsl2, p0[r] + nBref); }
#pragma unroll
    for (int r = 0; r < 16; ++r) { const float d1 = tq + (float)(32 + (r & 3) + 8 * (r >> 2)); p1[r] = fmaf(fabsf(d1), nsl2, p1[r] + nBref); }
  }
#pragma unroll
  for (int r = 0; r < 16; ++r) p0[r] = __builtin_amdgcn_exp2f(p0[r]);
}
__device__ __forceinline__ void finishSM_fast(f32x16& p0, f32x16& p1, float& l_reg, bf16x8& pa0, bf16x8& pa1, bf16x8& pa2, bf16x8& pa3) {
#pragma unroll
  for (int r = 0; r < 16; ++r) p1[r] = __builtin_amdgcn_exp2f(p1[r]);
  float ps = 0;
#pragma unroll
  for (int r = 0; r < 16; ++r) ps += p0[r];
#pragma unroll
  for (int r = 0; r < 16; ++r) ps += p1[r];
  { auto rr = __builtin_amdgcn_permlane32_swap(__float_as_uint(ps), __float_as_uint(ps), false, false);
    ps = __uint_as_float(rr[0]) + __uint_as_float(rr[1]); }
  l_reg += ps;
#define PK4(P, BASE, OUT) do { unsigned a0 = pk2(P[BASE + 0], P[BASE + 1]), a1 = pk2(P[BASE + 2], P[BASE + 3]);   \
    unsigned b0 = pk2(P[BASE + 4], P[BASE + 5]), b1 = pk2(P[BASE + 6], P[BASE + 7]);                              \
    auto r0 = __builtin_amdgcn_permlane32_swap(a0, b0, false, false); auto r1 = __builtin_amdgcn_permlane32_swap(a1, b1, false, false); \
    v4u w = {r0[0], r1[0], r0[1], r1[1]}; OUT = *reinterpret_cast<bf16x8*>(&w); } while (0)
  PK4(p0, 0, pa0); PK4(p0, 8, pa1); PK4(p1, 0, pa2); PK4(p1, 8, pa3);
#undef PK4
}
constexpr int RING_SLOT = SHM_V + SHM_K, RING_NB = 4, FAST_WS_OFF = RING_NB * RING_SLOT;
template <int OFF> __device__ __forceinline__ bf16x8 lds_rd128(int addr) { bf16x8 r; asm volatile("ds_read_b128 %0, %1 offset:%2" : "=&v"(r) : "v"(addr), "i"(OFF) : "memory"); return r; }
template <int SLOT> __device__ __forceinline__ void qkt_ring2(f32x16& p0, f32x16& p1, const int (&kad)[4], const bf16x8* qr, bool aug, v4u ka0, v4u ka1, v4u qa) {
  constexpr int KB = SLOT * RING_SLOT + SHM_V;
  const int k0a = kad[0] + KB, k1a = kad[1] + KB, k2a = kad[2] + KB, k3a = kad[3] + KB;
  const bf16x8 a0 = lds_rd128<0>(k0a), b0 = lds_rd128<32 * 128>(k0a), a1 = lds_rd128<0>(k1a), b1 = lds_rd128<32 * 128>(k1a);
  const bf16x8 a2 = lds_rd128<0>(k2a), b2 = lds_rd128<32 * 128>(k2a), a3 = lds_rd128<0>(k3a), b3 = lds_rd128<32 * 128>(k3a);
  p0 = f32x16{}; p1 = f32x16{};
  asm volatile("s_waitcnt lgkmcnt(0)" ::: "memory"); SBAR();
  p0 = __builtin_amdgcn_mfma_f32_32x32x16_bf16(a0, qr[0], p0, 0, 0, 0); p1 = __builtin_amdgcn_mfma_f32_32x32x16_bf16(b0, qr[0], p1, 0, 0, 0);
  p0 = __builtin_amdgcn_mfma_f32_32x32x16_bf16(a1, qr[1], p0, 0, 0, 0); p1 = __builtin_amdgcn_mfma_f32_32x32x16_bf16(b1, qr[1], p1, 0, 0, 0);
  p0 = __builtin_amdgcn_mfma_f32_32x32x16_bf16(a2, qr[2], p0, 0, 0, 0); p1 = __builtin_amdgcn_mfma_f32_32x32x16_bf16(b2, qr[2], p1, 0, 0, 0);
  p0 = __builtin_amdgcn_mfma_f32_32x32x16_bf16(a3, qr[3], p0, 0, 0, 0); p1 = __builtin_amdgcn_mfma_f32_32x32x16_bf16(b3, qr[3], p1, 0, 0, 0);
  if (aug) {
    p0 = __builtin_amdgcn_mfma_f32_32x32x16_bf16(*reinterpret_cast<bf16x8*>(&ka0), *reinterpret_cast<bf16x8*>(&qa), p0, 0, 0, 0);
    p1 = __builtin_amdgcn_mfma_f32_32x32x16_bf16(*reinterpret_cast<bf16x8*>(&ka1), *reinterpret_cast<bf16x8*>(&qa), p1, 0, 0, 0); }
}
template <int c, int VAR> __device__ __forceinline__ void attn_map_fast(LAS unsigned char* lds, const bf16* __restrict__ QKV, float* stash, bf16* __restrict__ MIX, const float* __restrict__ subln_g,
                                               int h, int i0, float lam, float sl2, int W, float Bref) {
  int tid_ = threadIdx.x; asm volatile("" : "+v"(tid_));
  asm volatile("" : "+s"(QKV), "+s"(stash), "+s"(MIX), "+s"(subln_g), "+s"(h), "+s"(i0), "+s"(W));
  const int tid = tid_, wid = tid >> 6, lane = tid & 63, r32 = lane & 31, hi = lane >> 5;
  const int wave_u = __builtin_amdgcn_readfirstlane(wid);
  LAS float* li_l = (LAS float*)(lds + FAST_WS_OFF) + wid * 64;
  const int lds0 = (int)(unsigned)(uintptr_t)lds;
  const int vb0 = lds0 + v_rd_base(lane);
  int kad[4];
#pragma unroll
  for (int d0 = 0; d0 < 4; ++d0) kad[d0] = lds0 + KSWZ64(r32, d0 * 32 + hi * 16);
  int goK, goV0, goV1;
  { const int row = tid >> 3, lc = (tid & 7) ^ ((row >> 1) & 7); goK = row * LDK + lc * 8; }
#define VSRC(L, OUT) do { const int sub_ = (L) >> 5, rem_ = (L) & 31, kk_ = ((sub_ >> 2) << 3) | (rem_ >> 2), cc_ = ((sub_ & 3) << 5) | ((rem_ & 3) << 3); \
    const int k_ = (kk_ & ~0xC) | ((kk_ & 4) << 1) | ((kk_ & 8) >> 1); OUT = k_ * LDK + cc_; } while (0)
  VSRC(tid, goV0); VSRC(512 + tid, goV1);
#undef VSRC
  const int iw = i0 + wave_u * 32, qi = iw + r32; const float nsl2 = -sl2, nBref = -Bref;
  int jlo = (i0 - W > 0 ? i0 - W : 0) >> 6, jhi = (i0 + 255 + W < T - 1 ? i0 + 255 + W : T - 1) >> 6;
  while (((jhi - jlo + 1) & 3) != 0) { if (jhi < T / KVBLK - 1) ++jhi; else --jlo; }
  const int NT = jhi - jlo + 1;
  const float s1f = __uint_as_float(bfbits(sl2) << 16), s2f = __uint_as_float(bfbits(sl2 - s1f) << 16), s3f = __uint_as_float(bfbits(sl2 - s1f - s2f) << 16);
  const unsigned S1 = bfbits(s1f), S2 = bfbits(s2f), S3 = bfbits(s3f), II = bfbits((float)r32), J0 = bfbits((float)r32), J1 = bfbits((float)(32 + r32)), ONE = 0x3f80u, NEG = 0x8000u;
  v4u qa = hi ? (v4u){0u, 0u, 0u, 0u} : (v4u){S1 | (S2 << 16), S3 | (II << 16), II | (II << 16), 0u};
  v4u ka0 = hi ? (v4u){ONE, 0u, 0u, 0u} : (v4u){J0 | (J0 << 16), J0 | ((S1 ^ NEG) << 16), (S2 ^ NEG) | ((S3 ^ NEG) << 16), ONE | (ONE << 16)};
  v4u ka1 = hi ? (v4u){ONE, 0u, 0u, 0u} : (v4u){J1 | (J1 << 16), J1 | ((S1 ^ NEG) << 16), (S2 ^ NEG) | ((S3 ^ NEG) << 16), ONE | (ONE << 16)};
  const unsigned flipm = hi ? 0u : 0x80008000u;
  bool right_signs = false;
#define TILE_SETUP(tile, MIXED) do { const int k0_ = (jlo + (tile)) * KVBLK; const bool left_ = k0_ + 63 <= iw, right_ = k0_ >= iw + 31; MIXED = !(left_ || right_); \
    if (right_ && !right_signs) { right_signs = true; ka0.x ^= flipm; ka0.y ^= flipm; ka0.z ^= flipm; ka1.x ^= flipm; ka1.y ^= flipm; ka1.z ^= flipm; } \
    const int dd_ = iw - k0_; const float c_ = nsl2 * (float)(dd_ < 0 ? -dd_ : dd_) + nBref; \
    const unsigned w1_ = bfbits(c_); const float r1_ = c_ - __uint_as_float(w1_ << 16); const unsigned w2_ = bfbits(r1_); const float r2_ = r1_ - __uint_as_float(w2_ << 16); const unsigned w3_ = bfbits(r2_); \
    if (hi) qa.x = w3_; else qa.w = w1_ | (w2_ << 16); } while (0)
  {
    const bf16* Kh = QKV + 2048 + h * 128 + c * 64; const bf16* Vh = QKV + 4096 + h * 128;
    float l_reg = 0; f32x16 o[4] = {}; bf16x8 qr[4];
    { const bf16* Qw = QKV + (size_t)qi * LDK + h * 128 + c * 64 + hi * 8;
#pragma unroll
      for (int d0 = 0; d0 < 4; ++d0) qr[d0] = *(const GAS bf16x8*)(Qw + d0 * 16); }
#define DMA(tile, SLOT) do { if (VAR & 8) break; const int tt_ = (tile) < NT ? (tile) : NT - 1; const size_t kb_ = (size_t)((jlo + tt_) * KVBLK) * LDK; \
    __builtin_amdgcn_global_load_lds((const unsigned*)(Vh + kb_ + goV0), (LAS unsigned*)(lds + (SLOT) * RING_SLOT + wave_u * 1024), 16, 0, 0); \
    __builtin_amdgcn_global_load_lds((const unsigned*)(Vh + kb_ + goV1), (LAS unsigned*)(lds + (SLOT) * RING_SLOT + 8192 + wave_u * 1024), 16, 0, 0); \
    __builtin_amdgcn_global_load_lds((const unsigned*)(Kh + kb_ + goK), (LAS unsigned*)(lds + (SLOT) * RING_SLOT + SHM_V + wave_u * 1024), 16, 0, 0); } while (0)
#define RBAR() do { if (VAR & 16) break; asm volatile("s_waitcnt vmcnt(3)" ::: "memory"); __builtin_amdgcn_s_barrier(); asm volatile("" ::: "memory"); } while (0)
#define TQ(tile) ((float)((jlo + (tile)) * KVBLK + 4 * hi - qi))
    f32x16 pA0 = {}, pA1 = {}, pB0 = {}, pB1 = {}; bf16x8 pa0 = {}, pa1 = {}, pa2 = {}, pa3 = {}; bool mx; const bool lead = wave_u < 4;
    asm volatile("s_waitcnt vmcnt(0)" ::: "memory");
    __syncthreads();
    DMA(0, 0); DMA(1, 1); DMA(2, 2);
    asm volatile("s_waitcnt vmcnt(6)" ::: "memory"); __builtin_amdgcn_s_barrier(); asm volatile("" ::: "memory");
#define TSTEP_A(tt, SLOT, PREV, PC0, PC1, PP0, PP1, HASPREV) do { \
        TILE_SETUP(tt, mx); \
        if (!(VAR & 4)) qkt_ring2<SLOT>(PC0, PC1, kad, qr, !mx, ka0, ka1, qa); \
        if (HASPREV) { if (!(VAR & 2)) finishSM_fast(PP0, PP1, l_reg, pa0, pa1, pa2, pa3); SBAR(); if (!(VAR & 1)) pv_d0(o, vb0 + (PREV) * RING_SLOT, pa0, pa1, pa2, pa3); } \
        if (!(VAR & 2)) partialSM_fast(PC0, PC1, mx, TQ(tt), nsl2, nBref); } while (0)
#define TSTEP_B(tt, SLOT, PREV, PC0, PC1, PP0, PP1, HASPREV) do { \
        TILE_SETUP(tt, mx); \
        if (HASPREV) { if (!(VAR & 2)) finishSM_fast(PP0, PP1, l_reg, pa0, pa1, pa2, pa3); SBAR(); } \
        if (!(VAR & 4)) qkt_ring2<SLOT>(PC0, PC1, kad, qr, !mx, ka0, ka1, qa); \
        if (!(VAR & 2)) partialSM_fast(PC0, PC1, mx, TQ(tt), nsl2, nBref); SBAR(); \
        if (HASPREV) { if (!(VAR & 1)) pv_d0(o, vb0 + (PREV) * RING_SLOT, pa0, pa1, pa2, pa3); } } while (0)
#define TLOOP(TS) _Pragma("unroll 1") for (int t = 0; t < NT; t += 4) { \
      TS(t, 0, 3, pA0, pA1, pB0, pB1, t > 0);      RBAR(); DMA(t + 3, 3); \
      TS(t + 1, 1, 0, pB0, pB1, pA0, pA1, true);   RBAR(); DMA(t + 4, 0); \
      TS(t + 2, 2, 1, pA0, pA1, pB0, pB1, true);   RBAR(); DMA(t + 5, 1); \
      TS(t + 3, 3, 2, pB0, pB1, pA0, pA1, true);   RBAR(); DMA(t + 6, 2); }
    if (lead) { TLOOP(TSTEP_A) } else { TLOOP(TSTEP_B) }
#undef TSTEP_A
#undef TSTEP_B
#undef TLOOP
    finishSM_fast(pB0, pB1, l_reg, pa0, pa1, pa2, pa3); SBAR(); pv_d0(o, vb0 + 3 * RING_SLOT, pa0, pa1, pa2, pa3);
    asm volatile("s_waitcnt vmcnt(0)" ::: "memory");
    map_epilogue<c>(o, l_reg, li_l, stash, MIX, subln_g, lam, h, i0, tid, wid, r32, hi);
#undef DMA
#undef RBAR
#undef TQ
#undef TILE_SETUP
  }
}
template <int VAR> __device__ __forceinline__ void attn_unit(LAS unsigned char* lds, const bf16* __restrict__ QKV, float* stash, bf16* __restrict__ MIX, const float* __restrict__ subln_g,
                                          int h, int i0, float lam, float sl2, float qn2a, float kn2a, float qn2b, float kn2b) {
  const float Ba = sqrtf(qn2a * kn2a) * 1.0001f + 0.01f, Bb = sqrtf(qn2b * kn2b) * 1.0001f + 0.01f;
  const bool fa = __builtin_amdgcn_readfirstlane((int)(2.0f * Ba < 100.0f)) != 0, fb = __builtin_amdgcn_readfirstlane((int)(2.0f * Bb < 100.0f)) != 0;
  const float wa = (fa ? 134.0f : 2.0f * Ba + THR2 + 134.0f) / sl2, wb = (fb ? 134.0f : 2.0f * Bb + THR2 + 134.0f) / sl2;
  const int W0 = __builtin_amdgcn_readfirstlane(wa < 16384.0f ? (int)wa + 1 : 16384), W1 = __builtin_amdgcn_readfirstlane(wb < 16384.0f ? (int)wb + 1 : 16384);
  if (fa) attn_map_fast<0, VAR>(lds, QKV, stash, MIX, subln_g, h, i0, lam, sl2, W0, Ba); else attn_map<0>(lds, QKV, stash, MIX, subln_g, h, i0, lam, sl2, W0);
  if (fb) attn_map_fast<1, VAR>(lds, QKV, stash, MIX, subln_g, h, i0, lam, sl2, W1, Bb); else attn_map<1>(lds, QKV, stash, MIX, subln_g, h, i0, lam, sl2, W1);
}
}

namespace scan {
constexpr int CH = 16, NCH = T / CH;
constexpr int VEC_OFF = 0, VEC_BYTES = CH * 5 * 64 * 4;
constexpr int VV_OFF = 2 * VEC_BYTES, VV_BYTES = CH * 32 * 4;
constexpr int YP_OFF = VV_OFF + 2 * VV_BYTES, YP_BYTES = CH * 512 * 4;
constexpr int SCAN_LDS = YP_OFF + 2 * YP_BYTES;
struct ConvJob { const float* wg; const float* wu; const float* wd; bf16* WGU2; bf16* WD2; int wave_gid, n_waves; };
constexpr int CV_GATE = (D / 64) * (FF / 32), CV_DOWN = (FF / 64) * (D / 32), CV_ITEMS = 2 * CV_GATE + CV_DOWN;
constexpr int CV_SCR_OFF = 110592, CV_SCR_BYTES = 64 * 33 * 4;
static_assert(TAIL_GU <= CV_GATE && TAIL_WD2 < CV_DOWN, "tail splits");
struct Tensors { const bf16* R; const bf16* K; const bf16* KK; const bf16* V; const float* DEC[2]; const float* A[2]; const float* k_a; float* Y[2]; const float* r_k; float* BON[2]; };

template <int var> __device__ __forceinline__ void scan_unit(LAS unsigned char* lds, const Tensors& P, const ConvJob& CJ, int h, int dir, int rg, float* dummy) {
    int tid_ = threadIdx.x; asm volatile("" : "+v"(tid_));
    const int tid = tid_, wave = __builtin_amdgcn_readfirstlane(tid >> 6), lane = tid & 63;
    const float* DEC = dir ? P.DEC[1] : P.DEC[0]; const float* AA = dir ? P.A[1] : P.A[0]; float* Y = dir ? P.Y[1] : P.Y[0]; float* BON = dir ? P.BON[1] : P.BON[0]; if (var & 1) { Y = dummy; BON = dummy; }
    const int chan0 = h * 64, row0 = chan0 + 32 * rg;
    const int hw = wave - 4;
#define DECLSET(n) v2u k##n, kk##n, r##n, v##n; f32x4 w##n, a##n
    DECLSET(0); DECLSET(1); DECLSET(2); DECLSET(3);
    const int hi_ = lane >> 4, hq = lane & 15;
    f32x4 kav = *(const GAS f32x4*)(P.k_a + chan0 + 4 * hq), rkv = *(const GAS f32x4*)(P.r_k + chan0 + 4 * hq);
    asm volatile("" : "+v"(kav), "+v"(rkv));
#define TSTEP(step) (dir ? (T - 1 - (step)) : (step))
#define HLOAD(n, chunk) do { const int t_ = TSTEP((chunk) * CH + hw * 4 + hi_); const size_t ix = (size_t)t_ * DR + chan0 + 4 * hq; \
        k##n = *(const GAS v2u*)(P.K + ix); kk##n = *(const GAS v2u*)(P.KK + ix); r##n = *(const GAS v2u*)(P.R + ix); w##n = *(const GAS f32x4*)(DEC + ix); a##n = *(const GAS f32x4*)(AA + ix); \
        v##n = *(const GAS v2u*)(P.V + (size_t)t_ * DR + row0 + 4 * (hq & 7)); } while (0)
#define HSTAGE(n, buf, chunk) do { LAS f32x4* vp = (LAS f32x4*)(lds + VEC_OFF + (buf) * VEC_BYTES) + (hw * 4 + hi_) * 80 + hq; const f32x4 kkf_ = bf4_to_f32(kk##n); \
        const f32x4 kd_ = bf4_to_f32(k##n) * (1.0f + (a##n - 1.0f) * kav), rf_ = bf4_to_f32(r##n); \
        vp[0] = -kkf_; vp[16] = w##n; vp[32] = kkf_ * a##n; vp[48] = kd_; vp[64] = rf_; \
        if (hq < 8) ((LAS f32x4*)(lds + VV_OFF + (buf) * VV_BYTES))[(hw * 4 + hi_) * 8 + hq] = bf4_to_f32(v##n); \
          \
        const float bs_ = row16_sum(dot4(rf_ * kd_, rkv)); \
        if (hq == 0) BON[(size_t)TSTEP(((chunk) < NCH ? (chunk) : NCH - 1) * CH + hw * 4 + hi_) * NHR + h] = bs_; } while (0)
#define HREDUCE1(buf, chunk, oi) do { const int s_ = (oi) >> 5, rr_ = (oi) & 31; \
        const LAS f32x4* yp = (const LAS f32x4*)(lds + YP_OFF + (buf) * YP_BYTES) + s_ * 128 + (rr_ >> 3) * 32 + ((rr_ >> 2) & 1) * 16 + (rr_ & 3) * 4; \
        const f32x4 a_ = yp[0], b_ = yp[1], c_ = yp[2], d_ = yp[3]; const f32x4 e_ = (a_ + b_) + (c_ + d_); \
        Y[(size_t)TSTEP((chunk) * CH + s_) * DR + row0 + rr_] = (e_.x + e_.y) + (e_.z + e_.w); } while (0)
#define HREDUCE(buf, chunk) do { HREDUCE1(buf, chunk, hw * 64 + lane); HREDUCE1(buf, chunk, hw * 64 + lane + 256); } while (0)
    const int q = lane & 15, rw = lane >> 4;
    f32x2 A01 = {0.f, 0.f}, A23 = {0.f, 0.f}, B01 = {0.f, 0.f}, B23 = {0.f, 0.f};
    f32x4 cva[8], cvb[8]; int cv_it = CJ.wave_gid;
    int cva_it = CV_ITEMS, cvb_it = CV_ITEMS;
    LAS float* cscr = (LAS float*)(lds + CV_SCR_OFF + hw * CV_SCR_BYTES);
#define CV_DECODE(it, W_, N_, K_, WT_, k0_, n0_, dr_) do { int r_ = (it); if (r_ < 2 * CV_GATE) { const bool up_ = r_ >= CV_GATE; if (up_) r_ -= CV_GATE; W_ = up_ ? CJ.wu : CJ.wg; N_ = FF; K_ = D; WT_ = CJ.WGU2; \
        const int kb_ = r_ / (FF / 32), nb_ = r_ - kb_ * (FF / 32); k0_ = 64 * kb_; n0_ = 32 * nb_; dr_ = 256 * (n0_ >> 7) + (up_ ? 128 : 0) + (n0_ & 127); } \
      else { r_ -= 2 * CV_GATE; W_ = CJ.wd; N_ = D; K_ = FF; WT_ = CJ.WD2; const int kb_ = r_ / (D / 32), nb_ = r_ - kb_ * (D / 32); k0_ = 64 * kb_; n0_ = 32 * nb_; dr_ = n0_; } } while (0)
#define CV_LOAD(REG, HELD) do { HELD = cv_it; if (cv_it < CV_ITEMS) { const float* W_; int N_, K_, k0_, n0_, dr_; bf16* WT_; CV_DECODE(cv_it, W_, N_, K_, WT_, k0_, n0_, dr_); (void)K_; (void)WT_; (void)dr_; \
        const float* src_ = W_ + (size_t)(k0_ + (lane >> 3)) * N_ + n0_ + 4 * (lane & 7); \
        _Pragma("unroll") for (int i = 0; i < 8; ++i) REG[i] = *(const GAS f32x4*)(src_ + (size_t)(8 * i) * N_); \
        const int nx_ = cv_it + CJ.n_waves; cv_it = (cv_it < 2 * CV_GATE && nx_ >= 2 * CV_GATE) ? nx_ + TAIL_WD2 : nx_; } } while (0)
#define CV_STORE(REG, HELD) do { if (HELD < CV_ITEMS) { const float* W_; int N_, K_, k0_, n0_, dr_; bf16* WT_; CV_DECODE(HELD, W_, N_, K_, WT_, k0_, n0_, dr_); (void)W_; (void)N_; \
        _Pragma("unroll") for (int i = 0; i < 8; ++i) { LAS float* d_ = cscr + (8 * i + (lane >> 3)) * 33 + 4 * (lane & 7); d_[0] = REG[i].x; d_[1] = REG[i].y; d_[2] = REG[i].z; d_[3] = REG[i].w; } \
        asm volatile("s_waitcnt lgkmcnt(0)" ::: "memory"); \
        _Pragma("unroll") for (int j = 0; j < 4; ++j) { const int n_ = (lane >> 3) + 8 * j; const LAS float* s_ = cscr + (8 * (lane & 7)) * 33 + n_; \
            v4u o_; o_.x = pk2(s_[0 * 33], s_[1 * 33]); o_.y = pk2(s_[2 * 33], s_[3 * 33]); o_.z = pk2(s_[4 * 33], s_[5 * 33]); o_.w = pk2(s_[6 * 33], s_[7 * 33]); \
            *(GAS v4u*)(WT_ + (size_t)(dr_ + n_) * K_ + k0_ + 8 * (lane & 7)) = o_; } \
        asm volatile("s_waitcnt lgkmcnt(0)" ::: "memory"); HELD = CV_ITEMS; } } while (0)
#define CHUNK_BAR() do { asm volatile("s_waitcnt lgkmcnt(0)" ::: "memory"); __builtin_amdgcn_s_barrier(); asm volatile("" ::: "memory"); } while (0)
#define CHUNK_SCAN(c, BUF) do { if (!(var & 16)) { \
            const LAS f32x4* vec = (const LAS f32x4*)(lds + VEC_OFF + (BUF) * VEC_BYTES) + q; \
            const LAS float* vv = (const LAS float*)(lds + VV_OFF + (BUF) * VV_BYTES) + 8 * (wave & 3) + rw; \
            LAS float* ypw = (LAS float*)(lds + YP_OFF + (BUF) * YP_BYTES) + (wave & 3) * 128 + lane; \
            f32x4 VS[4][5]; float VA[4], VB[4];                     \
            _Pragma("unroll") for (int p = 0; p < 3; ++p) { _Pragma("unroll") for (int e = 0; e < 5; ++e) VS[p][e] = vec[p * 80 + e * 16]; VA[p] = vv[p * 32]; VB[p] = vv[p * 32 + 4]; } \
            _Pragma("unroll") for (int s = 0; s < CH; ++s) { \
                if (s + 3 < CH) { _Pragma("unroll") for (int e = 0; e < 5; ++e) VS[(s + 3) & 3][e] = vec[(s + 3) * 80 + e * 16]; VA[(s + 3) & 3] = vv[(s + 3) * 32]; VB[(s + 3) & 3] = vv[(s + 3) * 32 + 4]; } \
                const f32x4 nkk4 = VS[s & 3][0], w4 = VS[s & 3][1], b4 = VS[s & 3][2], kd4 = VS[s & 3][3], r4 = VS[s & 3][4]; const float va = VA[s & 3], vb = VB[s & 3]; \
                const f32x2 n01 = {nkk4.x, nkk4.y}, n23 = {nkk4.z, nkk4.w}, w01 = {w4.x, w4.y}, w23 = {w4.z, w4.w}, b01 = {b4.x, b4.y}, b23 = {b4.z, b4.w}, k01 = {kd4.x, kd4.y}, k23 = {kd4.z, kd4.w}, r01 = {r4.x, r4.y}, r23 = {r4.z, r4.w}; \
                const f32x2 ppa = A01 * n01 + A23 * n23, ppb = B01 * n01 + B23 * n23; \
                const float saa = row16_sum(ppa.x + ppa.y), sab = row16_sum(ppb.x + ppb.y); \
                const f32x2 sa2 = {saa, saa}, sb2 = {sab, sab}, va2 = {va, va}, vb2 = {vb, vb}; \
                A01 = A01 * w01 + (sa2 * b01 + va2 * k01); A23 = A23 * w23 + (sa2 * b23 + va2 * k23); \
                B01 = B01 * w01 + (sb2 * b01 + vb2 * k01); B23 = B23 * w23 + (sb2 * b23 + vb2 * k23); \
                const f32x2 ya = A01 * r01 + A23 * r23, yb = B01 * r01 + B23 * r23; \
                if (!(var & 8)) { ypw[s * 512] = ya.x + ya.y; ypw[s * 512 + 64] = yb.x + yb.y; } \
            } } \
        CHUNK_BAR(); } while (0)
#define CHUNK_HELP(c, BUF, ST, LD, CONV) do { if (!(var & 32)) { \
            if (!(var & 4)) { HLOAD(LD, ((c) + 4 < NCH ? (c) + 4 : NCH - 1));         \
            HSTAGE(ST, (BUF) ^ 1, (c) + 1); }                                 \
            if (!(var & 2)) HREDUCE((BUF) ^ 1, ((c) >= 1 ? (c) - 1 : 0)); CONV;            \
        } \
        CHUNK_BAR(); } while (0)
    __syncthreads();
    if (wave >= 4) { HLOAD(0, 0); HLOAD(1, 1); HLOAD(2, 2); HLOAD(3, 3); HSTAGE(0, 0, 0); }
    __syncthreads();
    if (wave < 4 || (var & 64)) {
#pragma unroll 1
        for (int c = 0; c < NCH; c += 4) { CHUNK_SCAN(c, 0); CHUNK_SCAN(c + 1, 1); CHUNK_SCAN(c + 2, 0); CHUNK_SCAN(c + 3, 1); }
    } else {
#pragma unroll 1
        for (int c = 0; c < NCH; c += 4) {
            CHUNK_HELP(c, 0, 1, 0, CV_LOAD(cva, cva_it)); CHUNK_HELP(c + 1, 1, 2, 1, CV_LOAD(cvb, cvb_it)); CHUNK_HELP(c + 2, 0, 3, 2, CV_STORE(cva, cva_it)); CHUNK_HELP(c + 3, 1, 0, 3, CV_STORE(cvb, cvb_it)); }
    }
    if (wave >= 4) HREDUCE((NCH - 1) & 1, NCH - 1);
    asm volatile("s_waitcnt vmcnt(0)" ::: "memory");
#undef TSTEP
#undef HLOAD
#undef HSTAGE
#undef HREDUCE
#undef HREDUCE1
#undef CHUNK_SCAN
#undef CHUNK_HELP
#undef CHUNK_BAR
#undef CV_DECODE
#undef CV_LOAD
#undef CV_STORE
#undef DECLSET
}
}

enum { I_X = 0, I_F1_PRE, I_F1_WG, I_F1_WU, I_F1_WD, I_F1_POST, I_MIX_PRE, I_WIN, I_MU_PREV, I_MU_NEXT, I_W0F, I_W2F, I_W0B, I_W2B, I_A0F, I_A2F, I_A0B, I_A2B, I_G2, I_KK, I_KA, I_RK, I_GNW, I_GNB,
       I_LQ1, I_LK1, I_LQ2, I_LK2, I_SUBLN, I_WOUT, I_MIX_POST, I_F2_PRE, I_F2_WG, I_F2_WU, I_F2_WD, I_F2_POST, I_FINAL, N_IN };
constexpr int NORM_W = 32768, QCTR_W = 32768 + 128;
struct Args { const float* in[N_IN]; float* out; unsigned char* ws; int ph_lo, ph_hi, li, pad; };
static_assert(sizeof(Args) == (N_IN + 2) * 8 + 16, "Args has no padding");

__global__ void __launch_bounds__(NWAVES * 64, 2) hyb_fwd(Args args) {
    extern __shared__ __attribute__((aligned(16))) unsigned char lds_raw[];
    LAS unsigned char* lds = (LAS unsigned char*)lds_raw;
    volatile LAS unsigned* MISC = (volatile LAS unsigned*)(lds + MISC_OFF);
    const int tid0 = threadIdx.x;
    const int G = gridDim.x, bx = blockIdx.x, vcu = (G % 8 == 0) ? (bx % 8) * (G / 8) + bx / 8 : bx;
    const int NGW = G * NWAVES;
#define PHASE_IDS() int tid = threadIdx.x; asm volatile("" : "+v"(tid)); const int lane = tid & 63, wave = __builtin_amdgcn_readfirstlane(tid >> 6), gw = vcu * NWAVES + wave; (void)lane; (void)gw; \
    LAS float* const scr = (LAS float*)(lds + RING_OFF + wave * 16384); (void)scr
    unsigned char* ws = args.ws;
    for (int u = tid0; u < (LDS_BYTES - LDSCTL_OFF) / 4; u += NWAVES * 64) ((LAS unsigned*)(lds + LDSCTL_OFF))[u] = 0u;
    __syncthreads();
    const int lo = args.ph_lo, hi = args.ph_hi;
    unsigned* const barw = (unsigned*)(ws + WS_CTL) + 1024 + args.li * 4096;
    XcdBarrier bar; bar.bar = barw; bar.x = 0; bar.st = nullptr;
    if (hi - lo > 1) bar = xcd_barrier_post(barw, MISC + 8);
#if defined(PHASE_MASK)
#define IN(k) (((PHASE_MASK >> (k)) & 1) && lo <= (k) && (k) < hi)
#elif defined(ONLY_PHASE)
#define IN(k) ((k) == ONLY_PHASE && lo <= (k) && (k) < hi)
#else
#define IN(k) (lo <= (k) && (k) < hi)
#endif
#define SEAM(k) do { if (IN(k) && IN((k) + 1)) xcd_barrier(bar); } while (0)
    bf16* const WGU = (bf16*)(ws + WS_WGU); bf16* const WD = (bf16*)(ws + WS_WD); bf16* const WIN = (bf16*)(ws + WS_WIN); bf16* const WOUT = (bf16*)(ws + WS_WOUT);
    bf16* const WGU2 = (bf16*)(ws + WS_WGU2); bf16* const WD2 = (bf16*)(ws + WS_WD2);
    bf16* const W2T = (bf16*)(ws + WS_W2T); bf16* const A2T = (bf16*)(ws + WS_A2T); bf16* const G2T = (bf16*)(ws + WS_G2T);
    bf16* const XN = (bf16*)(ws + WS_XN); bf16* const HID = (bf16*)(ws + WS_HID); bf16* const Fb = (bf16*)(ws + WS_F); bf16* const Hb = (bf16*)(ws + WS_H);
    bf16* const PR = (bf16*)(ws + WS_PR); bf16* const QKV = (bf16*)(ws + WS_QKV);
    bf16* const Rb = (bf16*)(ws + WS_R); bf16* const Kb = (bf16*)(ws + WS_K); bf16* const Vb = (bf16*)(ws + WS_V); bf16* const KKb = (bf16*)(ws + WS_KK);
    bf16* const HWb = (bf16*)(ws + WS_HW); bf16* const XAb = (bf16*)(ws + WS_XA); bf16* const SGb = (bf16*)(ws + WS_SG);
    float* const DECF = (float*)(ws + WS_DECF); float* const DECB = (float*)(ws + WS_DECB); float* const AFb = (float*)(ws + WS_AF); float* const ABb = (float*)(ws + WS_AB); bf16* const Gb = (bf16*)(ws + WS_G);
    float* const BONF = (float*)(ws + WS_BONF); float* const BONB = (float*)(ws + WS_BONB);
    float* const YF = (float*)(ws + WS_YF); float* const YB = (float*)(ws + WS_YB); float* const O1 = (float*)(ws + WS_O1);

    if (IN(0)) { PHASE_IDS();
        conv_mat<1>(args.in[I_F1_WG], D, FF, WGU, scr, gw, NGW, lane);
        conv_mat<2>(args.in[I_F1_WU], D, FF, WGU, scr, gw, NGW, lane);
        conv_mat<0>(args.in[I_F1_WD], FF, D, WD, scr, gw, NGW, lane, G == 256 ? TAIL_WD : 0);
        conv_mat<3>(args.in[I_WIN], D, 12736, WIN, scr, gw, NGW, lane);
        if (G != 256) conv_mat<0>(args.in[I_WOUT], D, D, WOUT, scr, gw, NGW, lane);
        conv_mat<0>(args.in[I_G2], LK, DR, G2T, scr, gw, NGW, lane);
        conv_lora96(args.in[I_W2F], args.in[I_W2B], W2T, vcu * 512 + tid, G * 512);
        conv_lora96(args.in[I_A2F], args.in[I_A2B], A2T, vcu * 512 + tid, G * 512);
        for (int i = vcu * 512 + tid; i < 64 * 4096 / 8; i += G * 512) *(GAS v4u*)(WIN + (size_t)RC * D + (size_t)i * 8) = (v4u){0u, 0u, 0u, 0u};
        xn_phase(lds + RING_OFF, args.in[I_X], args.in[I_F1_PRE], XN, gw, NGW, tid, lane);
    }
    SEAM(0);
    if (IN(1)) { PHASE_IDS(); __syncthreads();
        pg8::Gemm g{XN, WGU, T, 2 * FF, D}; pg8::StaticOrder S; S.init(T, 2 * FF, G, bx); pg8::EpiSwiGLU E{HID, FF};
        pg8::gemm_phase<pg8::EpiSwiGLU, pg8::StaticOrder, true, true>(lds + RING_OFF, g, S, E);
        if (G == 256 && bx >= 192) { __syncthreads(); conv_mat<0>(args.in[I_F1_WD], FF, D, WD, scr, (bx - 192) * NWAVES + wave, 64 * NWAVES, lane, 0, TAIL_WD); } }
    SEAM(1);
    if (IN(2)) { PHASE_IDS(); __syncthreads();
        pg8::Gemm g{HID, WD, T, D, FF}; pg8::StaticOrder S; S.init(T, D, G, bx); pg8::EpiBf16Out E{Fb, D};
        pg8::gemm_phase<pg8::EpiBf16Out, pg8::StaticOrder, true, true>(lds + RING_OFF, g, S, E); }
    SEAM(2);
    if (IN(3)) { PHASE_IDS();
        rr_phase<false, true>(lds + RING_OFF, Fb, args.in[I_X], 0.5f, args.in[I_F1_POST], args.in[I_MIX_PRE], Hb, XN, nullptr, gw, NGW, tid, lane); }
    SEAM(3);
    if (IN(4)) { PHASE_IDS(); __syncthreads();
        pg8::Gemm g{XN, WIN, T, NIN, D}; pg8::StaticOrder S; S.init(T, NIN, G, bx); pg8::EpiIn E{PR, QKV, QSCALE};
        pg8::gemm_phase<pg8::EpiIn, pg8::StaticOrder, true, true>(lds + RING_OFF, g, S, E);
        if (G == 256 && bx >= 64) { __syncthreads(); const int tg = (bx - 64) * NWAVES + wave, tn = 192 * NWAVES;
            conv_mat<0>(args.in[I_WOUT], D, D, WOUT, scr, tg, tn, lane);
            conv_mat<1>(args.in[I_F2_WG], D, FF, WGU2, scr, tg, tn, lane, 0, TAIL_GU); } }
    SEAM(4);
    if (IN(5)) { PHASE_IDS();
        PrepA P{PR, args.in[I_MU_PREV], args.in[I_MU_NEXT], args.in[I_KK], Rb, Kb, Vb, KKb, HWb, XAb, SGb};
        prep_phase(lds + RING_OFF, P, gw, NGW, tid, lane);
        { float mx[8] = {0.f, 0.f, 0.f, 0.f, 0.f, 0.f, 0.f, 0.f};
          qk_norm_rows(QKV, mx, gw, NGW, lane);
          LAS unsigned* nl = (LAS unsigned*)(lds + RING_OFF + 65536);
          if (tid < 64) nl[tid] = 0u;
          __syncthreads();
          if ((lane & 7) == 0) {
#pragma unroll
              for (int j = 0; j < 8; ++j) (void)__hip_atomic_fetch_max(nl + (lane >> 3) + 8 * j, __float_as_uint(mx[j]), __ATOMIC_RELAXED, __HIP_MEMORY_SCOPE_WORKGROUP); }
          __syncthreads();
          if (tid < 64) (void)__hip_atomic_fetch_max((unsigned*)(ws + WS_CTL) + NORM_W + tid, nl[tid], __ATOMIC_RELAXED, __HIP_MEMORY_SCOPE_AGENT);
        }
    }
    SEAM(5);
    if (IN(6)) { PHASE_IDS(); __syncthreads();
#if !defined(P6_ONLY) || P6_ONLY == 0
        { pg8::Gemm g{HWb, W2T, T, 4096, LK}; pg8::StaticOrder S; S.init(T, 4096, G, bx); pg8::EpiLora<0> E{DECF, DECB, args.in[I_W0F], args.in[I_W0B]};
          pg8::gemm_phase<pg8::EpiLora<0>, pg8::StaticOrder, true, true>(lds + RING_OFF, g, S, E); }
#endif
#if !defined(P6_ONLY) || P6_ONLY == 1
        __syncthreads();
        { pg8::Gemm g{XAb, A2T, T, 4096, LK}; pg8::StaticOrder S; S.init(T, 4096, G, bx); pg8::EpiLora<1> E{AFb, ABb, args.in[I_A0F], args.in[I_A0B]};
          pg8::gemm_phase<pg8::EpiLora<1>, pg8::StaticOrder, true, true>(lds + RING_OFF, g, S, E); }
#endif
#if !defined(P6_ONLY) || P6_ONLY == 2
        __syncthreads();
        { pg8::Gemm g{SGb, G2T, T, 2048, LK}; pg8::StaticOrder S; S.init(T, 2048, G, bx); pg8::EpiLora<2> E{Gb, Gb, nullptr, nullptr};
          pg8::gemm_phase<pg8::EpiLora<2>, pg8::StaticOrder, true, true>(lds + RING_OFF, g, S, E); }
#endif
    }
    SEAM(6);
    if (IN(7)) { PHASE_IDS();
        if ((bx < 128 || G != 256) && args.pad != 2) {
            scan::Tensors P{Rb, Kb, KKb, Vb, {DECF, DECB}, {AFb, ABb}, args.in[I_KA], {YF, YB}, args.in[I_RK], {BONF, BONB}};
            const scan::ConvJob CJ{args.in[I_F2_WG], args.in[I_F2_WU], args.in[I_F2_WD], WGU2, WD2, G == 256 ? TAIL_GU + bx * 4 + (wave & 3) : scan::CV_ITEMS, 512};
            const int su0 = (G == 256) ? (bx & 7) * 16 + (bx >> 3) : bx;
            #if defined(PROBE_VARIANT) && PROBE_VARIANT != 0
            if (args.pad != 0) { for (int su = su0; su < 128; su += (G == 256 ? 128 : G)) scan::scan_unit<PROBE_VARIANT>(lds + RING_OFF, P, CJ, su >> 2, (su >> 1) & 1, su & 1, (float*)(ws + WS_X1)); } else
#endif
            for (int su = su0; su < 128; su += (G == 256 ? 128 : G)) scan::scan_unit<0>(lds + RING_OFF, P, CJ, su >> 2, (su >> 1) & 1, su & 1, nullptr);
        }
        const float lam = __uint_as_float(__builtin_amdgcn_readfirstlane(__float_as_uint(__expf(wave_sum(args.in[I_LQ1][lane] * args.in[I_LK1][lane])) - __expf(wave_sum(args.in[I_LQ2][lane] * args.in[I_LK2][lane])) + LAM_INIT)));
        const unsigned* nrm = (const unsigned*)(ws + WS_CTL) + NORM_W;
        for (;;) {
            __syncthreads();
            if (tid == 0) MISC[12] = __hip_atomic_fetch_add((unsigned*)(ws + WS_CTL) + QCTR_W + (args.pad == 2 ? 64 : 0), 1u, __ATOMIC_RELAXED, __HIP_MEMORY_SCOPE_AGENT);
            __syncthreads();
            const int u = __builtin_amdgcn_readfirstlane((int)MISC[12]);
            if (u >= 512) break;
            const int h = 15 - (u >> 5), qb = u & 31;
            const float sl2 = exp2f(-0.5f * (float)(h + 1)) * 1.4426950408889634f;
#define NRM_LD(i) __uint_as_float(__builtin_amdgcn_readfirstlane(__hip_atomic_load(nrm + (i), __ATOMIC_RELAXED, __HIP_MEMORY_SCOPE_AGENT)))
            const float qa = NRM_LD(2 * h), ka = NRM_LD(32 + 2 * h), qb2 = NRM_LD(2 * h + 1), kb2 = NRM_LD(32 + 2 * h + 1);
#undef NRM_LD
#if defined(PROBE_ATTVAR)
            if (args.pad == 2) att::attn_unit<PROBE_ATTVAR>(lds + RING_OFF, QKV, (float*)(ws + WS_X1 + 128 * MiB) + (size_t)bx * 32768, (bf16*)(ws + WS_X1), args.in[I_SUBLN], h, qb * 256, lam, sl2, qa, ka, qb2, kb2); else
#endif
            att::attn_unit<0>(lds + RING_OFF, QKV, O1 + (size_t)bx * 32768, XN, args.in[I_SUBLN], h, qb * 256, lam, sl2, qa, ka, qb2, kb2); }
    }
    SEAM(7);
    if (IN(8)) { PHASE_IDS();
        PostR P{YF, YB, Vb, BONF, BONB, Gb, args.in[I_GNW], args.in[I_GNB], XN};
        for (int t_ = gw; t_ < T; t_ += NGW) { int t = t_; asm volatile("" : "+s"(t)); post_r_row(P, t, lane); }
    }
    SEAM(8);
    if (IN(9)) { PHASE_IDS(); __syncthreads();
        if (G != 256) {
            conv_mat<1>(args.in[I_F2_WG], D, FF, WGU2, scr, gw, NGW, lane);
            conv_mat<2>(args.in[I_F2_WU], D, FF, WGU2, scr, gw, NGW, lane);
            conv_mat<0>(args.in[I_F2_WD], FF, D, WD2, scr, gw, NGW, lane);
            __syncthreads(); }
        pg8::Gemm g{XN, WOUT, T, D, D}; pg8::StaticOrder S; S.init(T, D, G, bx); pg8::EpiBf16Out E{Fb, D};
        pg8::gemm_phase<pg8::EpiBf16Out, pg8::StaticOrder, true, true>(lds + RING_OFF, g, S, E); }
    SEAM(9);
    if (IN(10)) { PHASE_IDS();
        rr_phase<false, false>(lds + RING_OFF, Fb, Hb, 1.0f, args.in[I_MIX_POST], args.in[I_F2_PRE], Hb, XN, nullptr, gw, NGW, tid, lane); }
    SEAM(10);
    if (IN(11)) { PHASE_IDS(); __syncthreads();
        pg8::Gemm g{XN, WGU2, T, 2 * FF, D}; pg8::StaticOrder S; S.init(T, 2 * FF, G, bx); pg8::EpiSwiGLU E{HID, FF};
        pg8::gemm_phase<pg8::EpiSwiGLU, pg8::StaticOrder, true, true>(lds + RING_OFF, g, S, E);
        if (G == 256 && bx >= 192) { __syncthreads(); conv_mat<0>(args.in[I_F2_WD], FF, D, WD2, scr, (bx - 192) * NWAVES + wave, 64 * NWAVES, lane, 0, TAIL_WD2); } }
    SEAM(11);
    if (IN(12)) { PHASE_IDS(); __syncthreads();
        pg8::Gemm g{HID, WD2, T, D, FF}; pg8::StaticOrder S; S.init(T, D, G, bx); pg8::EpiBf16Out E{Fb, D};
        pg8::gemm_phase<pg8::EpiBf16Out, pg8::StaticOrder, true, true>(lds + RING_OFF, g, S, E); }
    SEAM(12);
    if (IN(13)) { PHASE_IDS();
        rr_phase<true, false>(lds + RING_OFF, Fb, Hb, 0.5f, args.in[I_F2_POST], args.in[I_FINAL], nullptr, nullptr, args.out, gw, NGW, tid, lane); }
#undef IN
#undef SEAM
}

extern "C" void kernel_launch(void* const* d_in, const int* in_sizes, int n_in, void* d_out, int out_size, void* d_ws, size_t ws_size, hipStream_t stream) {
    static int grid = 0;
    if (grid == 0) {
        if (n_in != N_IN || in_sizes[0] != T * D || out_size != T * D || ws_size < WS_END) { fprintf(stderr, "kernel_launch: shape/workspace mismatch (n_in %d, in0 %d, out %d, ws %zu, need %zu)\n", n_in, n_in > 0 ? in_sizes[0] : -1, out_size, ws_size, (size_t)WS_END); grid = -1; return; }
        int dev = 0, cus = 0, per_cu = 0;
        if (hipGetDevice(&dev) != hipSuccess || hipDeviceGetAttribute(&cus, hipDeviceAttributeMultiprocessorCount, dev) != hipSuccess) { grid = -1; return; }
        if (hipFuncSetAttribute((const void*)hyb_fwd, hipFuncAttributeMaxDynamicSharedMemorySize, LDS_BYTES) != hipSuccess) { fprintf(stderr, "kernel_launch: hipFuncSetAttribute failed\n"); grid = -1; return; }
        if (hipOccupancyMaxActiveBlocksPerMultiprocessor(&per_cu, (const void*)hyb_fwd, NWAVES * 64, LDS_BYTES) != hipSuccess || per_cu < 1) { fprintf(stderr, "kernel_launch: occupancy query says %d blocks per CU\n", per_cu); (void)hipGetLastError(); grid = -1; return; }
        grid = cus;
    }
    if (grid < 0) return;
    if (hipMemsetAsync((char*)d_ws + WS_CTL, 0, CTL_ZERO_BYTES, stream) != hipSuccess) return;
    Args a{};
    for (int i = 0; i < N_IN; ++i) a.in[i] = (const float*)d_in[i];
    a.out = (float*)d_out; a.ws = (unsigned char*)d_ws;
#if defined(PROBE_REPEAT)
#ifndef PROBE_PAD
#define PROBE_PAD 1
#endif
#ifndef PROBE_DELAY
#define PROBE_DELAY 0
#endif
    a.ph_lo = 0; a.ph_hi = PROBE_REPEAT + 1 + PROBE_DELAY; hipLaunchKernelGGL(hyb_fwd, dim3(grid), dim3(NWAVES * 64), LDS_BYTES, stream, a);
    a.ph_lo = PROBE_REPEAT; a.ph_hi = PROBE_REPEAT + 1; a.li = 1; a.pad = PROBE_PAD; hipLaunchKernelGGL(hyb_fwd, dim3(grid), dim3(NWAVES * 64), LDS_BYTES, stream, a);
    if (PROBE_REPEAT + 1 + PROBE_DELAY < N_PHASES) { a.ph_lo = PROBE_REPEAT + 1 + PROBE_DELAY; a.ph_hi = N_PHASES; a.li = 2; a.pad = 0; hipLaunchKernelGGL(hyb_fwd, dim3(grid), dim3(NWAVES * 64), LDS_BYTES, stream, a); }
#elif MK_ONE_LAUNCH
    a.ph_lo = 0; a.ph_hi = N_PHASES;
    hipLaunchKernelGGL(hyb_fwd, dim3(grid), dim3(NWAVES * 64), LDS_BYTES, stream, a);
#else
    for (int p = 0; p < N_PHASES; ++p) { a.ph_lo = p; a.ph_hi = p + 1; hipLaunchKernelGGL(hyb_fwd, dim3(grid), dim3(NWAVES * 64), LDS_BYTES, stream, a); }
#endif
    const hipError_t le = hipPeekAtLastError();
    if (le != hipSuccess) fprintf(stderr, "kernel_launch: launch failed: %s\n", hipGetErrorName(le));
}
```

```cpp
#include <hip/hip_runtime.h>
#include <cstdio>
#include <cstdint>

constexpr int T = 8192, D = 4096, FF = 11008, DR = 2048, RC = 6592, RCP = 6656, NIN = 12800, QKVW = 6144, NHR = 32, HN = 64, LK = 256;
constexpr int NDH = 16;
constexpr float NORM_EPS = 1e-6f, GN_EPS = 64e-5f, SUBLN_EPS = 1e-5f, LAM_INIT = 0.2f;
constexpr float QSCALE = 0.125f * 1.4426950408889634f;
#ifndef N_PHASES
#define N_PHASES 14
#endif
#ifndef MK_ONE_LAUNCH
#define MK_ONE_LAUNCH 1
#endif

namespace pg8 {
#define PG8_LAS __attribute__((address_space(3)))
typedef unsigned short bf16_t;
typedef short bf16x8 __attribute__((ext_vector_type(8)));
typedef float f32x4 __attribute__((ext_vector_type(4)));
typedef unsigned u32x4 __attribute__((ext_vector_type(4)));
constexpr int BM = 256, BK = 64, HALF = 128, HTB = HALF * BK * 2  , STAGE_BYTES = 8 * HTB, NXCD = 8, WGM = 8;

__host__ __device__ __forceinline__ int lds_byte(int r, int c) { const int st = (r >> 4) * 2 + (c >> 5), rr = r & 15, cc = c & 31, ob = rr * 64 + cc * 2; return st * 1024 + (ob ^ (((ob >> 9) & 1) << 5)); }
__host__ __device__ __forceinline__ void stage_rc(int b, int& R, int& C) { const int st = b / 1024, sb = b % 1024, swz = sb ^ (((sb >> 9) & 1) << 5); R = (st >> 1) * 16 + swz / 64; C = (st & 1) * 32 + (swz % 64) / 2; }
__host__ __device__ __forceinline__ int perm32(int rho) { const int n = rho >> 4, i = rho & 15; return 8 * (i >> 2) + 4 * n + (i & 3); }

struct Unit { int pm, pn; };
struct Gemm { const bf16_t* A; const bf16_t* Bt; int M, N, K; };

struct StaticOrder {
    int nM, nN, nwg, G, c;
    __host__ __device__ void init(int M, int N, int G_, int c_) { nM = M / BM; nN = N / BM; nwg = nM * nN; G = G_; c = c_; }
    __host__ __device__ bool next(int i, Unit& u) const {
        const long L = (long)i * G + c; if (L >= nwg) return false;
        int wgid = (int)L; { const int q = nwg / NXCD, r = nwg % NXCD, xcd = wgid % NXCD, off = wgid / NXCD; wgid = (xcd < r ? xcd * (q + 1) : r * (q + 1) + (xcd - r) * q) + off; }
        const int nig = WGM * nN, gid = wgid / nig, fm = gid * WGM, gsz = (nM - fm) < WGM ? (nM - fm) : WGM;
        u.pm = fm + ((wgid % nig) % gsz); u.pn = (wgid % nig) / gsz; return true;
    }
    __device__ __forceinline__ void a_ready(const Unit&) const {}
    __device__ __forceinline__ void done(const Unit&) const {}
};

__device__ __forceinline__ unsigned cvt_pk_bf16(float lo, float hi) { unsigned r; asm volatile("v_cvt_pk_bf16_f32 %0, %1, %2" : "=v"(r) : "v"(lo), "v"(hi)); return r; }
typedef unsigned u32x2 __attribute__((ext_vector_type(2)));
__device__ __forceinline__ float sigmoid_f(float x) { return __builtin_amdgcn_rcpf(1.0f + __builtin_amdgcn_exp2f(-1.4426950408889634f * x)); }

struct EpiF32 {
    static constexpr bool PERM = false, AFTER_DRAIN = false;
    float* C; int ldc;
    __device__ __forceinline__ void operator()(const f32x4 (&acc)[2][2][4][2], const Unit& u, int wr, int wc, int fr, int fq) const {
        const int row0 = u.pm * BM + wr * 64 + fr, col0 = u.pn * BM + wc * 32 + 4 * fq;
#pragma unroll
        for (int ai = 0; ai < 2; ++ai)
#pragma unroll
            for (int m = 0; m < 4; ++m) { float* rowp = C + (size_t)(row0 + ai * HALF + m * 16) * ldc + col0;
#pragma unroll
                for (int bj = 0; bj < 2; ++bj)
#pragma unroll
                    for (int n = 0; n < 2; ++n) *(f32x4*)(rowp + bj * HALF + n * 16) = acc[ai][bj][m][n]; }
    }
};
struct EpiBf16Out {
    static constexpr bool PERM = true, AFTER_DRAIN = false;
    bf16_t* O; int ldc;
    __device__ __forceinline__ void operator()(const f32x4 (&acc)[2][2][4][2], const Unit& u, int wr, int wc, int fr, int fq) const {
        const int row0 = u.pm * BM + wr * 64 + fr, col0 = u.pn * BM + wc * 32 + 8 * fq;
#pragma unroll
        for (int ai = 0; ai < 2; ++ai)
#pragma unroll
            for (int m = 0; m < 4; ++m) { bf16_t* rowp = O + (size_t)(row0 + ai * HALF + m * 16) * ldc + col0;
#pragma unroll
                for (int bj = 0; bj < 2; ++bj) { const f32x4 v0 = acc[ai][bj][m][0], v1 = acc[ai][bj][m][1];
                    u32x4 w; w.x = cvt_pk_bf16(v0[0], v0[1]); w.y = cvt_pk_bf16(v0[2], v0[3]); w.z = cvt_pk_bf16(v1[0], v1[1]); w.w = cvt_pk_bf16(v1[2], v1[3]);
                    *(u32x4*)(rowp + bj * HALF) = w; } }
    }
};
struct EpiSwiGLU {
    static constexpr bool PERM = true, AFTER_DRAIN = false;
    bf16_t* O; int ldc;
    __device__ __forceinline__ void operator()(const f32x4 (&acc)[2][2][4][2], const Unit& u, int wr, int wc, int fr, int fq) const {
        const int row0 = u.pm * BM + wr * 64 + fr, col0 = u.pn * HALF + wc * 32 + 8 * fq;
#pragma unroll
        for (int ai = 0; ai < 2; ++ai)
#pragma unroll
            for (int m = 0; m < 4; ++m) { bf16_t* rowp = O + (size_t)(row0 + ai * HALF + m * 16) * ldc + col0;
                float v[8];
#pragma unroll
                for (int n = 0; n < 2; ++n)
#pragma unroll
                    for (int j = 0; j < 4; ++j) { const float g = acc[ai][0][m][n][j], up = acc[ai][1][m][n][j]; v[n * 4 + j] = g * sigmoid_f(g) * up; }
                u32x4 w; w.x = cvt_pk_bf16(v[0], v[1]); w.y = cvt_pk_bf16(v[2], v[3]); w.z = cvt_pk_bf16(v[4], v[5]); w.w = cvt_pk_bf16(v[6], v[7]);
                *(u32x4*)rowp = w; }
    }
};
struct EpiIn {
    static constexpr bool PERM = false, AFTER_DRAIN = false;
    bf16_t* PR; bf16_t* QKV; float qs;
    __device__ __forceinline__ void operator()(const f32x4 (&acc)[2][2][4][2], const Unit& u, int wr, int wc, int fr, int fq) const {
        const int row0 = u.pm * BM + wr * 64 + fr; const bool rw = u.pn < 26;
        const int pc = rw ? u.pn : u.pn - 26, col0 = pc * BM + wc * 32 + 4 * fq, ld = rw ? 6656 : 6144; const float s = (!rw && pc < 8) ? qs : 1.0f;
        bf16_t* base = rw ? PR : QKV;
#pragma unroll
        for (int ai = 0; ai < 2; ++ai)
#pragma unroll
            for (int m = 0; m < 4; ++m) { bf16_t* rowp = base + (size_t)(row0 + ai * HALF + m * 16) * ld + col0;
#pragma unroll
                for (int bj = 0; bj < 2; ++bj)
#pragma unroll
                    for (int n = 0; n < 2; ++n) { const f32x4 v = acc[ai][bj][m][n] * s; u32x2 w; w.x = cvt_pk_bf16(v[0], v[1]); w.y = cvt_pk_bf16(v[2], v[3]);
                        *(u32x2*)(rowp + bj * HALF + n * 16) = w; } }
    }
};
template <int MODE> struct EpiLora {
    static constexpr bool PERM = false, AFTER_DRAIN = false;
    void* Of; void* Ob; const float* bf; const float* bb;
    __device__ __forceinline__ void operator()(const f32x4 (&acc)[2][2][4][2], const Unit& u, int wr, int wc, int fr, int fq) const {
        const int row0 = u.pm * BM + wr * 64 + fr; const bool back = u.pn >= 8; const int pc = back ? u.pn - 8 : u.pn, col0 = pc * BM + wc * 32 + 4 * fq;
        void* O = back ? Ob : Of; const float* bias = back ? bb : bf;
#pragma unroll
        for (int bj = 0; bj < 2; ++bj)
#pragma unroll
            for (int n = 0; n < 2; ++n) {
                const f32x4 bv = (MODE == 2) ? (f32x4){0.f, 0.f, 0.f, 0.f} : *(const f32x4*)(bias + col0 + bj * HALF + n * 16);
#pragma unroll
                for (int ai = 0; ai < 2; ++ai)
#pragma unroll
                    for (int m = 0; m < 4; ++m) { const size_t off = (size_t)(row0 + ai * HALF + m * 16) * 2048 + col0 + bj * HALF + n * 16;
                        f32x4 v = acc[ai][bj][m][n] + bv;
                        if (MODE == 0) {
#pragma unroll
                            for (int j = 0; j < 4; ++j) v[j] = __builtin_amdgcn_exp2f(-0.60653065971f * 1.4426950408889634f * sigmoid_f(v[j]));
                            *(f32x4*)((float*)O + off) = v; }
                        else if (MODE == 1) {
#pragma unroll
                                for (int j = 0; j < 4; ++j) v[j] = sigmoid_f(v[j]);
                            *(f32x4*)((float*)O + off) = v; }
                        else {
                            u32x2 w; w.x = cvt_pk_bf16(v[0], v[1]); w.y = cvt_pk_bf16(v[2], v[3]); *(u32x2*)((bf16_t*)O + off) = w; } }
                asm volatile("" ::: "memory"); }
    }
};

template <class Epi, class Sched, bool ALIGN_EPI = false, bool SP2 = false>
__device__ __forceinline__ void gemm_phase(PG8_LAS unsigned char* lds, const Gemm g, const Sched& S, const Epi& E) {
    int tid_ = threadIdx.x; asm volatile("" : "+v"(tid_));
    const int tid = tid_, wid = __builtin_amdgcn_readfirstlane(tid >> 6), lane = tid & 63, wr = wid >> 2, wc = wid & 3, fr = lane & 15, fq = lane >> 4;
    const int K = g.K, nt = K / BK;
    unsigned voffA[2], voffB[2];
#pragma unroll
    for (int i = 0; i < 2; ++i) { int R, C; stage_rc(tid * 16 + i * 8192, R, C); const int Rb = Epi::PERM ? ((R & ~31) + perm32(R & 31)) : R;
        voffA[i] = (unsigned)(R * K + C) * 2u; voffB[i] = (unsigned)(Rb * K + C) * 2u; }
    const size_t kstep = (size_t)(BK * 2);
    const size_t hstep = (size_t)HALF * K * 2;
    const size_t tstep = 2 * hstep;
    const unsigned ldsw = (unsigned)wid * 1024u;
    const int aoff = lds_byte(wr * 64 + fr, fq * 8), boff = lds_byte(wc * 32 + fr, fq * 8);
#define PG8_SA(b, h) (((b) * 2 + (h)) * HTB)
#define PG8_SB(b, h) ((4 + (b) * 2 + (h)) * HTB)
#define PG8_STAGE(bufoff, gbase, voff) do { _Pragma("unroll") for (int _i = 0; _i < 2; ++_i) \
        __builtin_amdgcn_global_load_lds((const unsigned*)((const char*)(gbase) + (voff)[_i]), (PG8_LAS unsigned*)(lds + (bufoff) + ldsw + _i * 8192), 16, 0, 0); } while (0)
#define PG8_LDA(dst, b, h) do { _Pragma("unroll") for (int m = 0; m < 4; ++m) _Pragma("unroll") for (int k = 0; k < 2; ++k) dst[m][k] = *(const PG8_LAS bf16x8*)(lds + PG8_SA(b, h) + aoff + m * 2048 + k * 1024); } while (0)
#define PG8_LDB(dst, b, h) do { _Pragma("unroll") for (int n = 0; n < 2; ++n) _Pragma("unroll") for (int k = 0; k < 2; ++k) dst[n][k] = *(const PG8_LAS bf16x8*)(lds + PG8_SB(b, h) + boff + n * 2048 + k * 1024); } while (0)
#define PG8_MMA(ai, bj, At, Bt) do { __builtin_amdgcn_s_setprio(1); _Pragma("unroll") for (int m = 0; m < 4; ++m) _Pragma("unroll") for (int n = 0; n < 2; ++n) _Pragma("unroll") for (int k = 0; k < 2; ++k) \
        acc[ai][bj][m][n] = __builtin_amdgcn_mfma_f32_16x16x32_bf16(Bt[n][k], At[m][k], acc[ai][bj][m][n], 0, 0, 0); __builtin_amdgcn_s_setprio(0); } while (0)
#define PG8_WAIT_V(n) asm volatile("s_waitcnt vmcnt(" #n ")" ::: "memory")
#define PG8_WAIT_L(n) asm volatile("s_waitcnt lgkmcnt(" #n ")" ::: "memory")
#define PG8_BAR __builtin_amdgcn_s_barrier()
#define PG8_SCHED __builtin_amdgcn_sched_barrier(0)
    Unit cur, nxt; int ui = 0;
    if (!S.next(0, cur)) return;
    f32x4 acc[2][2][4][2];
#pragma unroll
    for (int a = 0; a < 2; ++a)
#pragma unroll
        for (int b = 0; b < 2; ++b)
#pragma unroll
            for (int m = 0; m < 4; ++m)
#pragma unroll
                for (int n = 0; n < 2; ++n) acc[a][b][m][n] = (f32x4){0.f, 0.f, 0.f, 0.f};
    bf16x8 At[4][2], B0[2][2], B1[2][2];
    const char* cA = (const char*)g.A + (size_t)cur.pm * tstep; const char* cB = (const char*)g.Bt + (size_t)cur.pn * tstep;
    S.a_ready(cur);
    if constexpr (SP2) {
        PG8_STAGE(PG8_SB(0, 0), cB, voffB); PG8_STAGE(PG8_SB(0, 1), cB + hstep, voffB); PG8_STAGE(PG8_SA(0, 0), cA, voffA); PG8_STAGE(PG8_SA(0, 1), cA + hstep, voffA);
        if (wr == 1) PG8_BAR;
        PG8_WAIT_V(2); PG8_BAR;
        PG8_STAGE(PG8_SB(1, 0), cB + kstep, voffB); PG8_STAGE(PG8_SA(1, 0), cA + kstep, voffA); PG8_STAGE(PG8_SB(1, 1), cB + hstep + kstep, voffB);
        PG8_WAIT_V(6); PG8_BAR;
    } else {
        PG8_STAGE(PG8_SB(0, 0), cB, voffB); PG8_STAGE(PG8_SA(0, 0), cA, voffA); PG8_STAGE(PG8_SB(0, 1), cB + hstep, voffB); PG8_STAGE(PG8_SA(0, 1), cA + hstep, voffA);
        if (wr == 1) PG8_BAR;
        PG8_WAIT_V(4); PG8_BAR;
        PG8_STAGE(PG8_SB(1, 0), cB + kstep, voffB); PG8_STAGE(PG8_SA(1, 0), cA + kstep, voffA); PG8_STAGE(PG8_SB(1, 1), cB + hstep + kstep, voffB);
        PG8_WAIT_V(6); PG8_BAR;
    }
    for (;;) {
        const bool has_next = S.next(ui + 1, nxt);
        const char* nA = has_next ? (const char*)g.A + (size_t)nxt.pm * tstep : cA; const char* nB = has_next ? (const char*)g.Bt + (size_t)nxt.pn * tstep : cB;
_Pragma("unroll 1")
        for (int t = 0; t < nt; t += 2) {
            const bool last = (t == nt - 2);
            const char* a1 = cA + (size_t)(t + 1) * kstep;
            const char* a2 = last ? nA : cA + (size_t)(t + 2) * kstep; const char* b2 = last ? nB : cB + (size_t)(t + 2) * kstep;
            const char* a3 = a2 + kstep; const char* b3 = b2 + kstep;
            if (last && has_next) S.a_ready(nxt);
            if constexpr (SP2) {
            PG8_LDB(B0, 0, 0); PG8_LDB(B1, 0, 1); PG8_SCHED; PG8_LDA(At, 0, 0); PG8_STAGE(PG8_SA(1, 1), a1 + hstep, voffA);
            PG8_WAIT_V(8); PG8_WAIT_L(0); PG8_BAR; PG8_MMA(0, 0, At, B0); PG8_MMA(0, 1, At, B1); PG8_BAR; PG8_SCHED;
            PG8_LDA(At, 0, 1); PG8_STAGE(PG8_SB(0, 0), b2, voffB); PG8_STAGE(PG8_SB(0, 1), b2 + hstep, voffB); PG8_STAGE(PG8_SA(0, 0), a2, voffA);
            PG8_WAIT_V(8); PG8_WAIT_L(0); PG8_BAR; PG8_MMA(1, 0, At, B0); PG8_MMA(1, 1, At, B1); PG8_BAR; PG8_SCHED;
            PG8_LDB(B0, 1, 0); PG8_LDB(B1, 1, 1); PG8_SCHED; PG8_LDA(At, 1, 0); PG8_STAGE(PG8_SA(0, 1), a2 + hstep, voffA);
            PG8_WAIT_V(8); PG8_WAIT_L(0); PG8_BAR; PG8_MMA(0, 0, At, B0); PG8_MMA(0, 1, At, B1); PG8_BAR; PG8_SCHED;
            PG8_LDA(At, 1, 1); PG8_STAGE(PG8_SB(1, 0), b3, voffB); PG8_STAGE(PG8_SB(1, 1), b3 + hstep, voffB); PG8_STAGE(PG8_SA(1, 0), a3, voffA);
            PG8_WAIT_V(8); PG8_WAIT_L(0); PG8_BAR; PG8_MMA(1, 0, At, B0); PG8_MMA(1, 1, At, B1); PG8_BAR; PG8_SCHED;
            } else {
            PG8_LDB(B0, 0, 0); PG8_SCHED; PG8_LDA(At, 0, 0); PG8_STAGE(PG8_SA(1, 1), a1 + hstep, voffA);
            PG8_WAIT_L(8); PG8_BAR; PG8_WAIT_L(0); PG8_MMA(0, 0, At, B0); PG8_BAR; PG8_SCHED;
            PG8_LDB(B1, 0, 1); PG8_STAGE(PG8_SB(0, 0), b2, voffB);
            PG8_BAR; PG8_WAIT_L(0); PG8_MMA(0, 1, At, B1); PG8_BAR;
            PG8_LDA(At, 0, 1); PG8_STAGE(PG8_SA(0, 0), a2, voffA);
            PG8_BAR; PG8_WAIT_L(0); PG8_MMA(1, 0, At, B0); PG8_BAR; PG8_SCHED;
            PG8_STAGE(PG8_SB(0, 1), b2 + hstep, voffB);
            PG8_WAIT_V(6); PG8_BAR; PG8_MMA(1, 1, At, B1); PG8_BAR;
            PG8_LDB(B0, 1, 0); PG8_SCHED; PG8_LDA(At, 1, 0); PG8_STAGE(PG8_SA(0, 1), a2 + hstep, voffA);
            PG8_WAIT_L(8); PG8_BAR; PG8_WAIT_L(0); PG8_MMA(0, 0, At, B0); PG8_BAR; PG8_SCHED;
            PG8_LDB(B1, 1, 1); PG8_STAGE(PG8_SB(1, 0), b3, voffB);
            PG8_BAR; PG8_WAIT_L(0); PG8_MMA(0, 1, At, B1); PG8_BAR;
            PG8_LDA(At, 1, 1); PG8_STAGE(PG8_SA(1, 0), a3, voffA);
            PG8_BAR; PG8_WAIT_L(0); PG8_MMA(1, 0, At, B0); PG8_BAR; PG8_SCHED;
            PG8_STAGE(PG8_SB(1, 1), b3 + hstep, voffB);
            PG8_WAIT_V(6); PG8_BAR; PG8_MMA(1, 1, At, B1); PG8_BAR;
            }
        }
        if constexpr (ALIGN_EPI) { if (wr == 0) PG8_BAR; }
        if constexpr (!Epi::AFTER_DRAIN) { E(acc, cur, wr, wc, fr, fq); S.done(cur); }
        if (!has_next) break;
#pragma unroll
        for (int a = 0; a < 2; ++a)
#pragma unroll
            for (int b = 0; b < 2; ++b)
#pragma unroll
                for (int m = 0; m < 4; ++m)
#pragma unroll
                    for (int n = 0; n < 2; ++n) acc[a][b][m][n] = (f32x4){0.f, 0.f, 0.f, 0.f};
        cur = nxt; cA = nA; cB = nB; ++ui;
        if constexpr (ALIGN_EPI) { if (wr == 1) PG8_BAR; }
    }
    PG8_WAIT_V(0);
    if constexpr (!ALIGN_EPI) { if (wr == 0) PG8_BAR; }
    PG8_BAR;
    if constexpr (Epi::AFTER_DRAIN) { E.fused(acc, cur, wr, wc, fr, fq, lds, wid, lane); S.done(cur); }
#undef PG8_SA
#undef PG8_SB
#undef PG8_STAGE
#undef PG8_LDA
#undef PG8_LDB
#undef PG8_MMA
#undef PG8_WAIT_V
#undef PG8_WAIT_L
#undef PG8_BAR
#undef PG8_SCHED
}
}

constexpr size_t MiB = 1u << 20;
constexpr size_t WS_CTL = 0, CTL_ZERO_BYTES = 1 * MiB;
constexpr size_t WS_WGU = 1 * MiB, WS_WD = 173 * MiB;
constexpr size_t WS_WIN = 259 * MiB, WS_WOUT = 359 * MiB;
constexpr int TAIL_WD = 9216, TAIL_GU = 12288, TAIL_WD2 = 9216;
constexpr size_t WS_W2T = 391 * MiB, WS_A2T = 393 * MiB, WS_G2T = 395 * MiB;
constexpr size_t WS_XN = 396 * MiB;
constexpr size_t WS_HID = 460 * MiB;
constexpr size_t WS_F = 632 * MiB;
constexpr size_t WS_H = 760 * MiB;
constexpr size_t WS_X1 = 888 * MiB;
constexpr size_t WS_WGU2 = 1208 * MiB, WS_WD2 = WS_WIN;
constexpr size_t WS_END = 1380 * MiB;
constexpr size_t WS_R = 1 * MiB, WS_K = 65 * MiB, WS_V = 129 * MiB, WS_KK = 193 * MiB;
constexpr size_t WS_QKV = WS_HID, WS_YF = WS_HID + 96 * MiB, WS_HW = WS_HID + 160 * MiB, WS_XA = WS_HID + 164 * MiB, WS_SG = WS_HID + 168 * MiB;
constexpr size_t WS_YB = WS_F, WS_O1 = WS_F + 64 * MiB;
constexpr size_t WS_BONF = WS_HW, WS_BONB = WS_HW + 2 * MiB;
constexpr size_t WS_PR = WS_X1, WS_DECF = WS_X1, WS_DECB = WS_X1 + 64 * MiB, WS_AF = WS_X1 + 128 * MiB, WS_AB = WS_X1 + 192 * MiB, WS_G = WS_X1 + 256 * MiB;

constexpr int NWAVES = 8;
constexpr int RING_OFF = 0, RING_BYTES = 131072;
constexpr int LDSCTL_OFF = RING_BYTES, MISC_OFF = 146944;
constexpr int LDS_BYTES = 147456;

#define GAS __attribute__((address_space(1)))
#define LAS __attribute__((address_space(3)))
typedef unsigned short bf16;
typedef unsigned v4u __attribute__((ext_vector_type(4)));
typedef unsigned v2u __attribute__((ext_vector_type(2)));
typedef float f32x4 __attribute__((ext_vector_type(4)));
typedef float f32x2 __attribute__((ext_vector_type(2)));
typedef short bf16x8 __attribute__((ext_vector_type(8)));
typedef GAS unsigned gu32;
#define RLX_AGENT __ATOMIC_RELAXED, __HIP_MEMORY_SCOPE_AGENT
#define LDS_WAIT() asm volatile("s_waitcnt lgkmcnt(0)" ::: "memory")
#define VM_WAIT() asm volatile("s_waitcnt vmcnt(0)" ::: "memory")
__device__ __forceinline__ unsigned pk2(float lo, float hi) { unsigned r; asm volatile("v_cvt_pk_bf16_f32 %0, %1, %2" : "=v"(r) : "v"(lo), "v"(hi)); return r; }
__device__ __forceinline__ float sigm(float x) { return __builtin_amdgcn_rcpf(1.0f + __builtin_amdgcn_exp2f(-1.4426950408889634f * x)); }
#define XB_TMO      128
#define XB_XCNT(j)  (256  + 64 * (j))
#define XB_XSUB(j)  (1280 + 64 * (j))
#define XB_XGEN(j)  (2304 + 64 * (j))
#define XB_TOP      3328
#define XB_TOPGEN   3392
#define XCD_BAR_WORDS 3456
#define XB_SPIN_CAP (1u << 18)

__device__ __forceinline__ unsigned xb_ld(unsigned* p)              { return __hip_atomic_load(p, __ATOMIC_RELAXED, __HIP_MEMORY_SCOPE_AGENT); }
__device__ __forceinline__ unsigned xb_add(unsigned* p, unsigned v) { return __hip_atomic_fetch_add(p, v, __ATOMIC_RELAXED, __HIP_MEMORY_SCOPE_AGENT); }
__device__ __forceinline__ unsigned xb_xcc_id() { return (unsigned)__builtin_amdgcn_s_getreg((3 << 11) | 20) & 0xFu; }
#define XB_SPIN(cond, bar) do { unsigned _sp = 0; while (cond) { __builtin_amdgcn_s_sleep(1); \
    if ((++_sp & 255u) == 0u) { if (xb_ld(&(bar)[XB_TMO])) break; if (_sp > XB_SPIN_CAP) { atomicAdd(&(bar)[XB_TMO], 1u); break; } } } } while (0)

struct XcdBarrier {
    unsigned* bar; unsigned x;
    volatile LAS unsigned* st;
};

__device__ __forceinline__ XcdBarrier xcd_barrier_post(unsigned* bar, volatile LAS unsigned* st) {
    XcdBarrier b; b.bar = bar; b.x = xb_xcc_id(); b.st = st;
    if (threadIdx.x == 0) (void)xb_add(&bar[XB_XCNT(b.x)], 1u);
    return b;
}
__device__ __forceinline__ void xcd_barrier_complete(unsigned* bar, unsigned x, unsigned& nloc, unsigned& nx) {
    const unsigned G = gridDim.x * gridDim.y * gridDim.z;
    unsigned sum, cnt, mine, sp = 0u;
    for (;;) {
        sum = 0u; cnt = 0u; mine = 0u;
#pragma unroll
        for (unsigned j = 0; j < 16; ++j) { const unsigned c = xb_ld(&bar[XB_XCNT(j)]); sum += c; cnt += (c > 0u) ? 1u : 0u; mine = (j == x) ? c : mine; }
        if (sum == G) break;
        __builtin_amdgcn_s_sleep(1);
        if ((++sp & 255u) == 0u) { if (xb_ld(&bar[XB_TMO])) break; if (sp > XB_SPIN_CAP) { atomicAdd(&bar[XB_TMO], 1u); break; } }
    }
    nloc = mine > 0u ? mine : 1u; nx = cnt > 0u ? cnt : 1u;
}

__device__ __forceinline__ void xcd_barrier(const XcdBarrier& b) {
    asm volatile("s_waitcnt vmcnt(0)" ::: "memory");
    __syncthreads();
    if (threadIdx.x == 0) {
        unsigned* bar = b.bar;
        __builtin_amdgcn_s_waitcnt(0);
        unsigned nloc = b.st[0], nx = b.st[1];
        if (nloc == 0u) { xcd_barrier_complete(bar, b.x, nloc, nx); b.st[0] = nloc; b.st[1] = nx; }
        const unsigned old = xb_add(&bar[XB_XSUB(b.x)], 1u);
        const unsigned gen = old / nloc;
        if (old + 1u == (gen + 1u) * nloc) {
            __builtin_amdgcn_fence(__ATOMIC_RELEASE, "agent");
            asm volatile("s_waitcnt vmcnt(0)" ::: "memory");
            const unsigned og = xb_add(&bar[XB_TOP], 1u);
            const unsigned tg = og / nx;
            if (og + 1u == (tg + 1u) * nx) xb_add(&bar[XB_TOPGEN], 1u);
            else XB_SPIN(xb_ld(&bar[XB_TOPGEN]) == tg, bar);
            __builtin_amdgcn_fence(__ATOMIC_ACQUIRE, "agent");
            xb_add(&bar[XB_XGEN(b.x)], 1u);
            asm volatile("s_waitcnt vmcnt(0)" ::: "memory");
        } else {
            XB_SPIN(xb_ld(&bar[XB_XGEN(b.x)]) == gen, bar);
            __builtin_amdgcn_fence(__ATOMIC_ACQUIRE, "agent");
            asm volatile("s_waitcnt vmcnt(0)" ::: "memory");
        }
    }
    __syncthreads();
}

__device__ __forceinline__ float wave_sum(float v) {
#pragma unroll
    for (int o = 1; o < 64; o <<= 1) v += __shfl_xor(v, o);
    return v;
}
template <int N> __device__ __forceinline__ float dpp_ror(float x) { return __int_as_float(__builtin_amdgcn_update_dpp(0, __float_as_int(x), 0x120 + N, 0xf, 0xf, false)); }
__device__ __forceinline__ float row16_sum(float x) { x += dpp_ror<8>(x); x += dpp_ror<4>(x); x += dpp_ror<2>(x); x += dpp_ror<1>(x); return x; }
__device__ __forceinline__ float sum4(f32x4 v) { return (v.x + v.y) + (v.z + v.w); }
__device__ __forceinline__ float dot4(f32x4 a, f32x4 b) { return (a.x * b.x + a.y * b.y) + (a.z * b.z + a.w * b.w); }
__device__ __forceinline__ float ld_sc1(const float* p) { return __hip_atomic_load(p, __ATOMIC_RELAXED, __HIP_MEMORY_SCOPE_AGENT); }

__device__ __forceinline__ void transpose_item(const float* W, int K, int N, bf16* WT, int dst_row0, LAS float* scr, int k0, int n0, int lane) {
    const float* src = W + (size_t)(k0 + (lane >> 3)) * N + n0 + 4 * (lane & 7);
    f32x4 v[8];
#pragma unroll
    for (int i = 0; i < 8; ++i) v[i] = *(const GAS f32x4*)(src + (size_t)(8 * i) * N);
#pragma unroll
    for (int i = 0; i < 8; ++i) { LAS float* d = scr + (8 * i + (lane >> 3)) * 33 + 4 * (lane & 7); d[0] = v[i].x; d[1] = v[i].y; d[2] = v[i].z; d[3] = v[i].w; }
    LDS_WAIT(); asm volatile("" ::: "memory");
    const int c = lane & 7;
#pragma unroll
    for (int j = 0; j < 4; ++j) { const int n = (lane >> 3) + 8 * j; const LAS float* s = scr + (8 * c) * 33 + n;
        v4u o; o.x = pk2(s[0 * 33], s[1 * 33]); o.y = pk2(s[2 * 33], s[3 * 33]); o.z = pk2(s[4 * 33], s[5 * 33]); o.w = pk2(s[6 * 33], s[7 * 33]);
        *(GAS v4u*)(WT + (size_t)(dst_row0 + n) * K + k0 + 8 * c) = o; }
    LDS_WAIT(); asm volatile("" ::: "memory");
}
template <int MAP> __device__ __forceinline__ void conv_mat(const float* W, int K, int N, bf16* WT, LAS float* scr, int gw, int NGW, int lane, int it_lo = 0, int it_hi = 0x7fffffff) {
    const int nblk = N / 32, nall = (K / 64) * nblk, nitems = nall < it_hi ? nall : it_hi;
    int it = it_lo + gw;
    if (it >= nitems) return;
    const int last = it + ((nitems - 1 - it) / NGW) * NGW;
    f32x4 va[8], vb[8], vc[8], vd[8];
#define CM_LOAD(V, IT) do { const int i_ = (IT) < last ? (IT) : last; const int kb_ = i_ / nblk, nb_ = i_ - kb_ * nblk; \
        const float* src_ = W + (size_t)(64 * kb_ + (lane >> 3)) * N + 32 * nb_ + 4 * (lane & 7); \
        _Pragma("unroll") for (int i = 0; i < 8; ++i) V[i] = *(const GAS f32x4*)(src_ + (size_t)(8 * i) * N); } while (0)
#define CM_STORE(V, IT) do { const int kb_ = (IT) / nblk, nb_ = (IT) - kb_ * nblk, n0_ = 32 * nb_, k0_ = 64 * kb_; int dr_ = n0_; \
        if (MAP == 1) dr_ = 256 * (n0_ >> 7) + (n0_ & 127); \
        if (MAP == 2) dr_ = 256 * (n0_ >> 7) + 128 + (n0_ & 127); \
        if (MAP == 3) dr_ = n0_ < RC ? n0_ : n0_ + (RCP - RC); \
        _Pragma("unroll") for (int i = 0; i < 8; ++i) { LAS float* d_ = scr + (8 * i + (lane >> 3)) * 33 + 4 * (lane & 7); d_[0] = V[i].x; d_[1] = V[i].y; d_[2] = V[i].z; d_[3] = V[i].w; } \
        LDS_WAIT(); asm volatile("" ::: "memory"); \
        _Pragma("unroll") for (int j = 0; j < 4; ++j) { const int n_ = (lane >> 3) + 8 * j; const LAS float* s_ = scr + (8 * (lane & 7)) * 33 + n_; \
            v4u o_; o_.x = pk2(s_[0 * 33], s_[1 * 33]); o_.y = pk2(s_[2 * 33], s_[3 * 33]); o_.z = pk2(s_[4 * 33], s_[5 * 33]); o_.w = pk2(s_[6 * 33], s_[7 * 33]); \
            *(GAS v4u*)(WT + (size_t)(dr_ + n_) * K + k0_ + 8 * (lane & 7)) = o_; } \
        LDS_WAIT(); asm volatile("" ::: "memory"); } while (0)
    CM_LOAD(va, it); CM_LOAD(vb, it + NGW); CM_LOAD(vc, it + 2 * NGW);
    for (; it <= last; it += 4 * NGW) {
        CM_LOAD(vd, it + 3 * NGW); CM_STORE(va, it);
        CM_LOAD(va, it + 4 * NGW); if (it + NGW <= last) CM_STORE(vb, it + NGW);
        CM_LOAD(vb, it + 5 * NGW); if (it + 2 * NGW <= last) CM_STORE(vc, it + 2 * NGW);
        CM_LOAD(vc, it + 6 * NGW); if (it + 3 * NGW <= last) CM_STORE(vd, it + 3 * NGW);
    }
#undef CM_LOAD
#undef CM_STORE
}
__device__ __forceinline__ void conv_lora96(const float* Wf, const float* Wb, bf16* WT, int gtid, int NT_) {
    for (int i = gtid; i < 4096 * 32; i += NT_) { const int n = i & 4095, k8 = i >> 12; const float* W = n < 2048 ? Wf : Wb; const int nn = n & 2047;
        v4u o = {0u, 0u, 0u, 0u};
        if (k8 < 12) { float v[8];
#pragma unroll
            for (int j = 0; j < 8; ++j) v[j] = W[(size_t)(8 * k8 + j) * 2048 + nn];
            o.x = pk2(v[0], v[1]); o.y = pk2(v[2], v[3]); o.z = pk2(v[4], v[5]); o.w = pk2(v[6], v[7]); }
        *(GAS v4u*)(WT + (size_t)n * 256 + 8 * k8) = o; }
}

template <typename Tv> __device__ __forceinline__ Tv gld(const void* base, unsigned off) { return *(const GAS Tv*)((const GAS char*)base + off); }
template <typename Tv> __device__ __forceinline__ void gst(void* base, unsigned off, Tv v) { *(GAS Tv*)((GAS char*)base + off) = v; }
__device__ __forceinline__ void row_norm_bf16(const float* xrow, const float* g, bf16* orow, LAS f32x4* rowbuf, int lane) {
    const unsigned l16 = (unsigned)lane * 16u, l8 = (unsigned)lane * 8u;
    float s = 0.f;
#pragma unroll 8
    for (int j = 0; j < 16; ++j) { const f32x4 v = gld<f32x4>(xrow, l16 + 1024u * j); rowbuf[lane + 64 * j] = v; s += dot4(v, v); }
    const float rstd = 1.0f / sqrtf(wave_sum(s) * (1.0f / D) + NORM_EPS);
#pragma unroll 8
    for (int j = 0; j < 16; ++j) { const f32x4 gg = gld<f32x4>(g, l16 + 1024u * j); const f32x4 o = rowbuf[lane + 64 * j] * rstd * gg; v2u w; w.x = pk2(o.x, o.y); w.y = pk2(o.z, o.w); gst<v2u>(orow, l8 + 512u * j, w); }
}
__device__ __forceinline__ f32x4 bf4_to_f32(v2u w) { return (f32x4){__uint_as_float(w.x << 16), __uint_as_float(w.x & 0xffff0000u), __uint_as_float(w.y << 16), __uint_as_float(w.y & 0xffff0000u)}; }
__device__ __forceinline__ v2u f32_to_bf4(f32x4 o) { v2u w; w.x = pk2(o.x, o.y); w.y = pk2(o.z, o.w); return w; }
template <bool LAST, bool BASE_F32> __device__ __forceinline__ void row_res_norm(const bf16* frow, const void* baserow, float scale, const float* ga, const float* gb, bf16* hrow, bf16* xnrow, float* outrow, LAS f32x4* rowbuf, int lane) {
    const unsigned l16 = (unsigned)lane * 16u, l8 = (unsigned)lane * 8u;
    float s = 0.f;
#pragma unroll 8
    for (int j = 0; j < 16; ++j) { const f32x4 v = bf4_to_f32(gld<v2u>(frow, l8 + 512u * j)); rowbuf[lane + 64 * j] = v; s += dot4(v, v); }
    const float rf = scale / sqrtf(wave_sum(s) * (1.0f / D) + NORM_EPS);
    float s2 = 0.f;
#pragma unroll 8
    for (int j = 0; j < 16; ++j) { const f32x4 b = BASE_F32 ? gld<f32x4>(baserow, l16 + 1024u * j) : bf4_to_f32(gld<v2u>(baserow, l8 + 512u * j)), g = gld<f32x4>(ga, l16 + 1024u * j);
        f32x4 h = b + rowbuf[lane + 64 * j] * rf * g;
        if (!LAST) { const v2u hw = f32_to_bf4(h); gst<v2u>(hrow, l8 + 512u * j, hw); h = bf4_to_f32(hw); }
        rowbuf[lane + 64 * j] = h; s2 += dot4(h, h); }
    const float rh = 1.0f / sqrtf(wave_sum(s2) * (1.0f / D) + NORM_EPS);
#pragma unroll 8
    for (int j = 0; j < 16; ++j) { const f32x4 g = gld<f32x4>(gb, l16 + 1024u * j); const f32x4 o = rowbuf[lane + 64 * j] * rh * g;
        if (LAST) gst<f32x4>(outrow, l16 + 1024u * j, o);
        else gst<v2u>(xnrow, l8 + 512u * j, f32_to_bf4(o)); }
}

__device__ __forceinline__ void unpack8(v4u w, f32x4& a, f32x4& b) { a = (f32x4){__uint_as_float(w.x << 16), __uint_as_float(w.x & 0xffff0000u), __uint_as_float(w.y << 16), __uint_as_float(w.y & 0xffff0000u)};
    b = (f32x4){__uint_as_float(w.z << 16), __uint_as_float(w.z & 0xffff0000u), __uint_as_float(w.w << 16), __uint_as_float(w.w & 0xffff0000u)}; }
__device__ __forceinline__ v4u pack8(f32x4 a, f32x4 b) { v4u w; w.x = pk2(a.x, a.y); w.y = pk2(a.z, a.w); w.z = pk2(b.x, b.y); w.w = pk2(b.z, b.w); return w; }
__device__ __forceinline__ void rr_load16(v4u (&r)[8], const bf16* row, unsigned l16) {
#pragma unroll
    for (int j = 0; j < 8; ++j) r[j] = gld<v4u>(row, l16 + 1024u * j); }
__device__ __forceinline__ void rr_loadx(f32x4 (&x)[16], const float* row, unsigned l32) {
#pragma unroll
    for (int j = 0; j < 8; ++j) { x[2 * j] = gld<f32x4>(row, l32 + 2048u * j); x[2 * j + 1] = gld<f32x4>(row, l32 + 2048u * j + 16u); } }
template <bool LAST, bool BASE_F32> __device__ __forceinline__ void rr_process(const v4u (&f)[8], const v4u (&b)[8], f32x4 (&x)[16], const float* xnext, float scale, const LAS f32x4* gal, const LAS f32x4* gbl,
                                                                               bf16* hrow, bf16* xnrow, float* outrow, int lane) {
    const unsigned l16 = (unsigned)lane * 16u, l32 = (unsigned)lane * 32u;
    float s = 0.f;
#pragma unroll
    for (int j = 0; j < 8; ++j) { f32x4 f0, f1; unpack8(f[j], f0, f1); s += dot4(f0, f0) + dot4(f1, f1); }
    const float rf = scale / sqrtf(wave_sum(s) * (1.0f / D) + NORM_EPS);
    float s2 = 0.f; v4u hb[8];
#pragma unroll
    for (int j = 0; j < 8; ++j) { f32x4 f0, f1, b0, b1; unpack8(f[j], f0, f1);
        if (BASE_F32) { b0 = x[2 * j]; b1 = x[2 * j + 1]; } else unpack8(b[j], b0, b1);
        const f32x4 g0 = gal[2 * lane + 128 * j], g1 = gal[2 * lane + 128 * j + 1];
        f32x4 h0 = b0 + f0 * rf * g0, h1 = b1 + f1 * rf * g1;
        if (!LAST) { const v4u hw = pack8(h0, h1); gst<v4u>(hrow, l16 + 1024u * j, hw); if (BASE_F32) hb[j] = hw; unpack8(hw, h0, h1); }
        s2 += dot4(h0, h0) + dot4(h1, h1); __builtin_amdgcn_sched_barrier(0); }
    if (BASE_F32) rr_loadx(x, xnext, l32);
    const float rh = 1.0f / sqrtf(wave_sum(s2) * (1.0f / D) + NORM_EPS);
#pragma unroll
    for (int j = 0; j < 8; ++j) { f32x4 h0, h1;
        if (BASE_F32) unpack8(hb[j], h0, h1);
        else { f32x4 f0, f1, b0, b1; unpack8(f[j], f0, f1); unpack8(b[j], b0, b1); const f32x4 g0 = gal[2 * lane + 128 * j], g1 = gal[2 * lane + 128 * j + 1];
            h0 = b0 + f0 * rf * g0; h1 = b1 + f1 * rf * g1; if (!LAST) unpack8(pack8(h0, h1), h0, h1); }
        const f32x4 g0 = gbl[2 * lane + 128 * j], g1 = gbl[2 * lane + 128 * j + 1];
        const f32x4 o0 = h0 * rh * g0, o1 = h1 * rh * g1;
        if (LAST) { gst<f32x4>(outrow, l32 + 2048u * j, o0); gst<f32x4>(outrow, l32 + 2048u * j + 16u, o1); }
        else gst<v4u>(xnrow, l16 + 1024u * j, pack8(o0, o1));
        __builtin_amdgcn_sched_barrier(0); }
}
template <bool LAST, bool BASE_F32> __device__ __forceinline__ void rr_phase(LAS unsigned char* ldsb, const bf16* F, const void* base, float scale, const float* ga, const float* gb, bf16* H, bf16* XNo, float* out,
                                                                             int gw, int NGW, int tid, int lane) {
    LAS f32x4* gal = (LAS f32x4*)ldsb; LAS f32x4* gbl = gal + 1024;
    __syncthreads();
    for (int i = tid; i < 1024; i += NWAVES * 64) { gal[i] = ((const GAS f32x4*)ga)[i]; gbl[i] = ((const GAS f32x4*)gb)[i]; }
    __syncthreads();
    const unsigned l16 = (unsigned)lane * 16u, l32 = (unsigned)lane * 32u;
    int m = gw; if (m >= T) return;
    v4u fA[8], fB[8], bA[8] = {}, bB[8] = {}; f32x4 x[16] = {};
    const bf16* B16 = (const bf16*)base; const float* BX = (const float*)base;
    rr_load16(fA, F + (size_t)m * D, l16);
    if (BASE_F32) rr_loadx(x, BX + (size_t)m * D, l32); else rr_load16(bA, B16 + (size_t)m * D, l16);
#pragma unroll 1
    for (; m < T; m += 2 * NGW) {
        const int m1 = m + NGW, m1c = m1 < T ? m1 : m, m2 = m + 2 * NGW, m2c = m2 < T ? m2 : m;
        rr_load16(fB, F + (size_t)m1c * D, l16); if (!BASE_F32) rr_load16(bB, B16 + (size_t)m1c * D, l16);
        rr_process<LAST, BASE_F32>(fA, bA, x, BX + (size_t)m1c * D, scale, gal, gbl, H + (size_t)m * D, XNo + (size_t)m * D, out + (size_t)m * D, lane);
        rr_load16(fA, F + (size_t)m2c * D, l16); if (!BASE_F32) rr_load16(bA, B16 + (size_t)m2c * D, l16);
        if (m1 < T) rr_process<LAST, BASE_F32>(fB, bB, x, BX + (size_t)m2c * D, scale, gal, gbl, H + (size_t)m1 * D, XNo + (size_t)m1 * D, out + (size_t)m1 * D, lane);
    }
}

__device__ __forceinline__ void xn_process(const f32x4 (&x)[16], const LAS f32x4* gl, bf16* orow, int lane) {
    float s = 0.f;
#pragma unroll
    for (int j = 0; j < 16; ++j) s += dot4(x[j], x[j]);
    const float rstd = 1.0f / sqrtf(wave_sum(s) * (1.0f / D) + NORM_EPS);
#pragma unroll
    for (int j = 0; j < 8; ++j) { const f32x4 o0 = x[2 * j] * rstd * gl[2 * lane + 128 * j], o1 = x[2 * j + 1] * rstd * gl[2 * lane + 128 * j + 1];
        gst<v4u>(orow, (unsigned)lane * 16u + 1024u * j, pack8(o0, o1)); __builtin_amdgcn_sched_barrier(0); }
}
__device__ __forceinline__ void xn_phase(LAS unsigned char* ldsb, const float* X, const float* g, bf16* XNo, int gw, int NGW, int tid, int lane) {
    LAS f32x4* gl = (LAS f32x4*)ldsb;
    __syncthreads();
    for (int i = tid; i < 1024; i += NWAVES * 64) gl[i] = ((const GAS f32x4*)g)[i];
    __syncthreads();
    const unsigned l32 = (unsigned)lane * 32u; int m = gw; if (m >= T) return;
    f32x4 xa[16], xb[16]; rr_loadx(xa, X + (size_t)m * D, l32);
#pragma unroll 1
    for (; m < T; m += 2 * NGW) { const int m1 = m + NGW, m1c = m1 < T ? m1 : m, m2 = m + 2 * NGW, m2c = m2 < T ? m2 : m;
        rr_loadx(xb, X + (size_t)m1c * D, l32); xn_process(xa, gl, XNo + (size_t)m * D, lane);
        rr_loadx(xa, X + (size_t)m2c * D, l32); if (m1 < T) xn_process(xb, gl, XNo + (size_t)m1 * D, lane); }
}

struct PrepA { const bf16* PR; const float* mu_prev; const float* mu_next; const float* k_k; bf16* R; bf16* K; bf16* V; bf16* KK; bf16* HW; bf16* XA; bf16* SG; };
__device__ __forceinline__ void prep_a_row(const PrepA& P, int t, int lane) {
    const bf16* cur = P.PR + (size_t)t * RCP; const bool hp = t > 0, hn = t < T - 1;
    const bf16* prv = cur - RCP; const bf16* nxt = cur + RCP;
#pragma unroll 2
    for (int j = 0; j < 26; ++j) {
        const int c0 = 4 * lane + 256 * j;
        if (c0 < RC) {
            const f32x4 c = bf4_to_f32(*(const GAS v2u*)(cur + c0));
            const f32x4 pv = hp ? bf4_to_f32(*(const GAS v2u*)(prv + c0)) : (f32x4){0.f, 0.f, 0.f, 0.f};
            const f32x4 nv = hn ? bf4_to_f32(*(const GAS v2u*)(nxt + c0)) : (f32x4){0.f, 0.f, 0.f, 0.f};
            const f32x4 mp = *(const GAS f32x4*)(P.mu_prev + c0), mn = *(const GAS f32x4*)(P.mu_next + c0);
            const f32x4 p = c + mp * (pv - c) + mn * (nv - c);
            if (j < 8) { *(GAS v2u*)(P.R + (size_t)t * DR + c0) = f32_to_bf4(p); }
            else if (j < 16) { const int cc = c0 - 2048; *(GAS v2u*)(P.K + (size_t)t * DR + cc) = f32_to_bf4(p);
                const f32x4 kv = p * *(const GAS f32x4*)(P.k_k + cc); const float ss = row16_sum(dot4(kv, kv));
                const float inv = 1.0f / fmaxf(sqrtf(ss), 1e-12f); *(GAS v2u*)(P.KK + (size_t)t * DR + cc) = f32_to_bf4(kv * inv); }
            else if (j < 24) { *(GAS v2u*)(P.V + (size_t)t * DR + (c0 - 4096)) = f32_to_bf4(p); }
            else if (c0 < 6240) { v2u w; w.x = pk2(tanhf(p.x), tanhf(p.y)); w.y = pk2(tanhf(p.z), tanhf(p.w)); *(GAS v2u*)(P.HW + (size_t)t * LK + (c0 - 6144)) = w; }
            else if (c0 < 6336) { v2u w; w.x = pk2(p.x, p.y); w.y = pk2(p.z, p.w); *(GAS v2u*)(P.XA + (size_t)t * LK + (c0 - 6240)) = w; }
            else { v2u w; w.x = pk2(sigm(p.x), sigm(p.y)); w.y = pk2(sigm(p.z), sigm(p.w)); *(GAS v2u*)(P.SG + (size_t)t * LK + (c0 - 6336)) = w; }
        }
    }
    if (lane < 40) { const v2u z = {0u, 0u}; *(GAS v2u*)(P.HW + (size_t)t * LK + 96 + 4 * lane) = z; *(GAS v2u*)(P.XA + (size_t)t * LK + 96 + 4 * lane) = z; }
}

__device__ __forceinline__ float sum8_lanes(float x) {
    x += __int_as_float(__builtin_amdgcn_update_dpp(0, __float_as_int(x), 0xB1, 0xf, 0xf, false));
    x += __int_as_float(__builtin_amdgcn_update_dpp(0, __float_as_int(x), 0x4E, 0xf, 0xf, false));
    x += __int_as_float(__builtin_amdgcn_update_dpp(0, __float_as_int(x), 0x141, 0xf, 0xf, false));
    return x; }
template <int NJ> struct PrepSet { v4u c[NJ], p[NJ], n[NJ]; };
template <int J0, int NJ> __device__ __forceinline__ void prep_load(PrepSet<4>& S, const bf16* cur, const bf16* prv, const bf16* nxt, unsigned l16) {
#pragma unroll
    for (int jj = 0; jj < NJ; ++jj) { const unsigned off = l16 + 1024u * (J0 + jj); S.c[jj] = gld<v4u>(cur, off); S.p[jj] = gld<v4u>(prv, off); S.n[jj] = gld<v4u>(nxt, off); } }
template <int J> __device__ __forceinline__ void prep_shift(const PrepSet<4>& S, int jj, bool hp, bool hn, const LAS f32x4* mup, const LAS f32x4* mun, int lane, f32x4& r0, f32x4& r1) {
    f32x4 c0, c1, p0, p1, n0, n1; unpack8(S.c[jj], c0, c1); unpack8(S.p[jj], p0, p1); unpack8(S.n[jj], n0, n1);
    const f32x4 z = {0.f, 0.f, 0.f, 0.f}; if (!hp) { p0 = z; p1 = z; } if (!hn) { n0 = z; n1 = z; }
    const f32x4 a0 = mup[2 * lane + 128 * J], a1 = mup[2 * lane + 128 * J + 1], b0 = mun[2 * lane + 128 * J], b1 = mun[2 * lane + 128 * J + 1];
    r0 = c0 + a0 * (p0 - c0) + b0 * (n0 - c0); r1 = c1 + a1 * (p1 - c1) + b1 * (n1 - c1); }
template <int J0> __device__ __forceinline__ void prep_store4(const PrepSet<4>& S, bool hp, bool hn, const LAS f32x4* mup, const LAS f32x4* mun, bf16* dst, int lane) {
#pragma unroll
    for (int jj = 0; jj < 4; ++jj) { f32x4 r0, r1;
        switch (jj) { case 0: prep_shift<J0 + 0>(S, 0, hp, hn, mup, mun, lane, r0, r1); break; case 1: prep_shift<J0 + 1>(S, 1, hp, hn, mup, mun, lane, r0, r1); break;
                      case 2: prep_shift<J0 + 2>(S, 2, hp, hn, mup, mun, lane, r0, r1); break; default: prep_shift<J0 + 3>(S, 3, hp, hn, mup, mun, lane, r0, r1); break; }
        gst<v4u>(dst, (unsigned)lane * 16u + 1024u * jj, pack8(r0, r1)); __builtin_amdgcn_sched_barrier(0); } }
__device__ __forceinline__ void prep_store_k(const PrepSet<4>& S, bool hp, bool hn, const LAS f32x4* mup, const LAS f32x4* mun, const LAS f32x4* kk4, bf16* dstK, bf16* dstKK, int lane) {
#pragma unroll
    for (int jj = 0; jj < 4; ++jj) { f32x4 r0, r1;
        switch (jj) { case 0: prep_shift<4>(S, 0, hp, hn, mup, mun, lane, r0, r1); break; case 1: prep_shift<5>(S, 1, hp, hn, mup, mun, lane, r0, r1); break;
                      case 2: prep_shift<6>(S, 2, hp, hn, mup, mun, lane, r0, r1); break; default: prep_shift<7>(S, 3, hp, hn, mup, mun, lane, r0, r1); break; }
        gst<v4u>(dstK, (unsigned)lane * 16u + 1024u * jj, pack8(r0, r1));
        const f32x4 k0 = r0 * kk4[2 * lane + 128 * jj], k1 = r1 * kk4[2 * lane + 128 * jj + 1]; const float ss = sum8_lanes(dot4(k0, k0) + dot4(k1, k1));
        const float inv = 1.0f / fmaxf(sqrtf(ss), 1e-12f); gst<v4u>(dstKK, (unsigned)lane * 16u + 1024u * jj, pack8(k0 * inv, k1 * inv)); __builtin_amdgcn_sched_barrier(0); } }
__device__ __forceinline__ void prep_store_l(const PrepSet<4>& S, bool hp, bool hn, const LAS f32x4* mup, const LAS f32x4* mun, bf16* hw, bf16* xa, bf16* sg, int lane) {
    f32x4 r0, r1; prep_shift<12>(S, 0, hp, hn, mup, mun, lane, r0, r1);
    if (lane < 12) { const f32x4 t0 = {tanhf(r0.x), tanhf(r0.y), tanhf(r0.z), tanhf(r0.w)}, t1 = {tanhf(r1.x), tanhf(r1.y), tanhf(r1.z), tanhf(r1.w)}; gst<v4u>(hw, (unsigned)lane * 16u, pack8(t0, t1)); }
    else if (lane < 24) gst<v4u>(xa, (unsigned)(lane - 12) * 16u, pack8(r0, r1));
    else if (lane < 56) { const f32x4 t0 = {sigm(r0.x), sigm(r0.y), sigm(r0.z), sigm(r0.w)}, t1 = {sigm(r1.x), sigm(r1.y), sigm(r1.z), sigm(r1.w)}; gst<v4u>(sg, (unsigned)(lane - 24) * 16u, pack8(t0, t1)); }
    if (lane < 20) { const v4u z = {0u, 0u, 0u, 0u}; gst<v4u>(hw, 192u + (unsigned)lane * 16u, z); gst<v4u>(xa, 192u + (unsigned)lane * 16u, z); }
}
__device__ __forceinline__ void prep_phase(LAS unsigned char* ldsb, const PrepA& P, int gw, int NGW, int tid, int lane) {
    LAS f32x4* mup = (LAS f32x4*)ldsb; LAS f32x4* mun = mup + 1664; LAS f32x4* kk4 = mun + 1664;
    __syncthreads();
    for (int i = tid; i < RC / 4; i += NWAVES * 64) { mup[i] = ((const GAS f32x4*)P.mu_prev)[i]; mun[i] = ((const GAS f32x4*)P.mu_next)[i]; }
    for (int i = tid; i < DR / 4; i += NWAVES * 64) kk4[i] = ((const GAS f32x4*)P.k_k)[i];
    __syncthreads();
    const unsigned l16 = (unsigned)lane * 16u;
    int t = gw; if (t >= T) return;
    PrepSet<4> A, B;
#define PREP_ROWS(tt) const bf16* cur_ = P.PR + (size_t)(tt) * RCP; const bf16* prv_ = (tt) > 0 ? cur_ - RCP : cur_; const bf16* nxt_ = (tt) < T - 1 ? cur_ + RCP : cur_
    { PREP_ROWS(t); prep_load<0, 4>(A, cur_, prv_, nxt_, l16); }
#pragma unroll 1
    for (; t < T; t += NGW) {
        const bool hp = t > 0, hn = t < T - 1; const int tn = t + NGW < T ? t + NGW : t;
        PREP_ROWS(t);
        prep_load<4, 4>(B, cur_, prv_, nxt_, l16);  prep_store4<0>(A, hp, hn, mup, mun, P.R + (size_t)t * DR, lane);
        prep_load<8, 4>(A, cur_, prv_, nxt_, l16);  prep_store_k(B, hp, hn, mup, mun, kk4, P.K + (size_t)t * DR, P.KK + (size_t)t * DR, lane);
        prep_load<12, 1>(B, cur_, prv_, nxt_, l16); prep_store4<8>(A, hp, hn, mup, mun, P.V + (size_t)t * DR, lane);
        { const bf16* c2 = P.PR + (size_t)tn * RCP; const bf16* p2 = tn > 0 ? c2 - RCP : c2; const bf16* n2 = tn < T - 1 ? c2 + RCP : c2; prep_load<0, 4>(A, c2, p2, n2, l16); }
        prep_store_l(B, hp, hn, mup, mun, P.HW + (size_t)t * LK, P.XA + (size_t)t * LK, P.SG + (size_t)t * LK, lane);
    }
#undef PREP_ROWS
}

__device__ __forceinline__ void qk_norm_row(const bf16* qkvrow, float (&mx)[8], int lane) {
#pragma unroll
    for (int j = 0; j < 8; ++j) { const v4u w = *(const GAS v4u*)(qkvrow + 8 * lane + 512 * j); float ss = 0.f;
#pragma unroll
        for (int e = 0; e < 4; ++e) { const float lo = __uint_as_float(w[e] << 16), hi = __uint_as_float(w[e] & 0xffff0000u); ss += lo * lo + hi * hi; }
        ss += __shfl_xor(ss, 1); ss += __shfl_xor(ss, 2); ss += __shfl_xor(ss, 4);
        mx[j] = fmaxf(mx[j], ss); }
}

__device__ __forceinline__ void qk_load(v4u (&w)[8], const bf16* qkvrow, unsigned l16) {
#pragma unroll
    for (int j = 0; j < 8; ++j) w[j] = gld<v4u>(qkvrow, l16 + 1024u * j); }
__device__ __forceinline__ void qk_acc(const v4u (&w)[8], float (&mx)[8]) {
#pragma unroll
    for (int j = 0; j < 8; ++j) { float ss = 0.f;
#pragma unroll
        for (int e = 0; e < 4; ++e) { const float lo = __uint_as_float(w[j][e] << 16), hi = __uint_as_float(w[j][e] & 0xffff0000u); ss += lo * lo + hi * hi; }
        mx[j] = fmaxf(mx[j], sum8_lanes(ss)); } }
__device__ __forceinline__ void qk_norm_rows(const bf16* QKV, float (&mx)[8], int gw, int NGW, int lane) {
    const unsigned l16 = (unsigned)lane * 16u; int t = gw; if (t >= T) return;
    v4u a[8], b[8]; qk_load(a, QKV + (size_t)t * QKVW, l16);
#pragma unroll 1
    for (; t < T; t += 2 * NGW) { const int t1 = t + NGW < T ? t + NGW : t, t2 = t + 2 * NGW < T ? t + 2 * NGW : t;
        qk_load(b, QKV + (size_t)t1 * QKVW, l16); qk_acc(a, mx); qk_load(a, QKV + (size_t)t2 * QKVW, l16); qk_acc(b, mx); }
}

struct PostR { const float* YF; const float* YB; const bf16* V; const float* BF; const float* BB; const bf16* G; const float* gn_w; const float* gn_b; bf16* MIX; };
__device__ __forceinline__ void post_r_row(const PostR& P, int t, int lane) {
    const size_t ro = (size_t)t * DR;
#pragma unroll 2
    for (int j = 0; j < 8; ++j) {
        const int c0 = 4 * lane + 256 * j; const size_t o = ro + c0; const int hd = (lane >> 4) + 4 * j;
        const f32x4 y = *(const GAS f32x4*)(P.YF + o) + *(const GAS f32x4*)(P.YB + o);
        const float mean = row16_sum(sum4(y)) * (1.0f / 64.0f); const f32x4 d = y - mean;
        const float var = row16_sum(dot4(d, d)) * (1.0f / 64.0f); const float rs = 1.0f / sqrtf(var + GN_EPS);
        const f32x4 yn = d * rs * *(const GAS f32x4*)(P.gn_w + c0) + *(const GAS f32x4*)(P.gn_b + c0);
        const f32x4 v = bf4_to_f32(*(const GAS v2u*)(P.V + o)), g = bf4_to_f32(*(const GAS v2u*)(P.G + o));
        const float bs = ((const GAS float*)P.BF)[(size_t)t * NHR + hd] + ((const GAS float*)P.BB)[(size_t)t * NHR + hd];
        const f32x4 out = (yn + bs * v) * g;
        v2u w; w.x = pk2(out.x, out.y); w.y = pk2(out.z, out.w); *(GAS v2u*)(P.MIX + (size_t)t * D + c0) = w;
    }
}

namespace att {
typedef short s16x4 __attribute__((ext_vector_type(4)));
typedef float f32x16 __attribute__((ext_vector_type(16)));
constexpr int KVBLK = 64, LDK = QKVW;
constexpr int SHM_V = 16384, SHM_K = 8192, V_OFF = 0, K_OFF = 2 * SHM_V, WS_OFF = K_OFF + 2 * SHM_K;
constexpr float THR2 = 11.5f;
#define KSWZ64(row, colB) ((row) * 128 + ((colB) ^ ((((row) >> 1) & 7) << 4)))
#define SBAR() __builtin_amdgcn_sched_barrier(0)
__device__ __forceinline__ int crow(int r, int hi) { return (r & 3) + 8 * (r >> 2) + 4 * hi; }
__device__ __forceinline__ void partialSM(f32x16& p0, f32x16& p1, float& m_reg, float& mn, float& alpha, float tq, float nsl2) {
#ifndef ATT_NOBIAS
#pragma unroll
  for (int r = 0; r < 16; ++r) { const float d0 = tq + (float)((r & 3) + 8 * (r >> 2)); p0[r] = fmaf(fabsf(d0), nsl2, p0[r]); }
#pragma unroll
  for (int r = 0; r < 16; ++r) { const float d1 = tq + (float)(32 + (r & 3) + 8 * (r >> 2)); p1[r] = fmaf(fabsf(d1), nsl2, p1[r]); }
#endif
  float pmax = p0[0];
#pragma unroll
  for (int r = 1; r < 16; ++r) pmax = fmaxf(pmax, p0[r]);
#pragma unroll
  for (int r = 0; r < 16; ++r) pmax = fmaxf(pmax, p1[r]);
  { auto rr = __builtin_amdgcn_permlane32_swap(__float_as_uint(pmax), __float_as_uint(pmax), false, false);
    pmax = fmaxf(__uint_as_float(rr[0]), __uint_as_float(rr[1])); }
  if (__builtin_expect(__all(pmax - m_reg <= THR2), 1)) { mn = m_reg; alpha = 1.f; }
  else { mn = fmaxf(m_reg, pmax); alpha = __builtin_amdgcn_exp2f(m_reg - mn); m_reg = mn; }
#pragma unroll
  for (int r = 0; r < 16; ++r) p0[r] = __builtin_amdgcn_exp2f(p0[r] - mn);
#pragma unroll
  for (int r = 0; r < 16; ++r) p1[r] = p1[r] - mn;
}
__device__ __forceinline__ void finishSM(f32x16& p0, f32x16& p1, float alpha, float& l_reg, bf16x8& pa0, bf16x8& pa1, bf16x8& pa2, bf16x8& pa3) {
#pragma unroll
  for (int r = 0; r < 16; ++r) p1[r] = __builtin_amdgcn_exp2f(p1[r]);
  float ps = 0;
#pragma unroll
  for (int r = 0; r < 16; ++r) ps += p0[r];
#pragma unroll
  for (int r = 0; r < 16; ++r) ps += p1[r];
  { auto rr = __builtin_amdgcn_permlane32_swap(__float_as_uint(ps), __float_as_uint(ps), false, false);
    ps = __uint_as_float(rr[0]) + __uint_as_float(rr[1]); }
  l_reg = l_reg * alpha + ps;
#define PK4(P, BASE, OUT) do { unsigned a0 = pk2(P[BASE + 0], P[BASE + 1]), a1 = pk2(P[BASE + 2], P[BASE + 3]);   \
    unsigned b0 = pk2(P[BASE + 4], P[BASE + 5]), b1 = pk2(P[BASE + 6], P[BASE + 7]);                              \
    auto r0 = __builtin_amdgcn_permlane32_swap(a0, b0, false, false); auto r1 = __builtin_amdgcn_permlane32_swap(a1, b1, false, false); \
    v4u w = {r0[0], r1[0], r0[1], r1[1]}; OUT = *reinterpret_cast<bf16x8*>(&w); } while (0)
  PK4(p0, 0, pa0); PK4(p0, 8, pa1); PK4(p1, 0, pa2); PK4(p1, 8, pa3);
#undef PK4
}
__device__ __forceinline__ void qkt(f32x16& p0, f32x16& p1, const LAS unsigned char* Ks, const bf16x8* qr, int r32, int hi) {
  p0 = f32x16{}; p1 = f32x16{};
#pragma unroll
  for (int d0 = 0; d0 < 4; ++d0) { const int cb = d0 * 32 + hi * 16;
    const bf16x8 b0 = *reinterpret_cast<const LAS bf16x8*>(Ks + KSWZ64(r32, cb));
    const bf16x8 b1 = *reinterpret_cast<const LAS bf16x8*>(Ks + KSWZ64(32 + r32, cb));
    p0 = __builtin_amdgcn_mfma_f32_32x32x16_bf16(b0, qr[d0], p0, 0, 0, 0);
    p1 = __builtin_amdgcn_mfma_f32_32x32x16_bf16(b1, qr[d0], p1, 0, 0, 0); }
}
__device__ __forceinline__ int v_st(int k, int c) { const int kk = (k & ~0xC) | ((k & 4) << 1) | ((k & 8) >> 1); return ((kk >> 3) * 4 + (c >> 5)) * 512 + ((kk & 7) * 32 + (c & 31)) * 2; }
__device__ __forceinline__ int v_rd_base(int lane) { return ((lane & 3) << 3) | (((lane >> 2) & 3) << 6) | (((lane >> 4) & 1) << 5) | (((lane >> 5) & 1) << 8); }
constexpr int v_rd_off(int d0, int ks, int half) { return d0 * 512 + ks * 4096 + half * 2048; }
template <int OFF> __device__ __forceinline__ s16x4 tr_read(int vb) {
  s16x4 r; asm volatile("ds_read_b64_tr_b16 %0, %1 offset:%2" : "=&v"(r) : "v"(vb), "i"(OFF) : "memory"); return r;
}
template <int D0> __device__ __forceinline__ void pv_one(f32x16& od, int vb, bf16x8 pa0, bf16x8 pa1, bf16x8 pa2, bf16x8 pa3) {
  const s16x4 l0 = tr_read<v_rd_off(D0, 0, 0)>(vb), h0 = tr_read<v_rd_off(D0, 0, 1)>(vb), l1 = tr_read<v_rd_off(D0, 1, 0)>(vb), h1 = tr_read<v_rd_off(D0, 1, 1)>(vb);
  const s16x4 l2 = tr_read<v_rd_off(D0, 2, 0)>(vb), h2 = tr_read<v_rd_off(D0, 2, 1)>(vb), l3 = tr_read<v_rd_off(D0, 3, 0)>(vb), h3 = tr_read<v_rd_off(D0, 3, 1)>(vb);
  asm volatile("s_waitcnt lgkmcnt(0)" ::: "memory"); SBAR();
#define PKV(L, H) (bf16x8){L[0], L[1], L[2], L[3], H[0], H[1], H[2], H[3]}
  od = __builtin_amdgcn_mfma_f32_32x32x16_bf16(pa0, PKV(l0, h0), od, 0, 0, 0);
  od = __builtin_amdgcn_mfma_f32_32x32x16_bf16(pa1, PKV(l1, h1), od, 0, 0, 0);
  od = __builtin_amdgcn_mfma_f32_32x32x16_bf16(pa2, PKV(l2, h2), od, 0, 0, 0);
  od = __builtin_amdgcn_mfma_f32_32x32x16_bf16(pa3, PKV(l3, h3), od, 0, 0, 0);
#undef PKV
}
#define PKV(L, H) (bf16x8){L[0], L[1], L[2], L[3], H[0], H[1], H[2], H[3]}
template <int D0> __device__ __forceinline__ void pv_rd(s16x4 (&v)[8], int vb) {
  v[0] = tr_read<v_rd_off(D0, 0, 0)>(vb); v[1] = tr_read<v_rd_off(D0, 0, 1)>(vb); v[2] = tr_read<v_rd_off(D0, 1, 0)>(vb); v[3] = tr_read<v_rd_off(D0, 1, 1)>(vb);
  v[4] = tr_read<v_rd_off(D0, 2, 0)>(vb); v[5] = tr_read<v_rd_off(D0, 2, 1)>(vb); v[6] = tr_read<v_rd_off(D0, 3, 0)>(vb); v[7] = tr_read<v_rd_off(D0, 3, 1)>(vb);
}
__device__ __forceinline__ void pv_mm(f32x16& od, const s16x4 (&v)[8], bf16x8 pa0, bf16x8 pa1, bf16x8 pa2, bf16x8 pa3) {
  od = __builtin_amdgcn_mfma_f32_32x32x16_bf16(pa0, PKV(v[0], v[1]), od, 0, 0, 0);
  od = __builtin_amdgcn_mfma_f32_32x32x16_bf16(pa1, PKV(v[2], v[3]), od, 0, 0, 0);
  od = __builtin_amdgcn_mfma_f32_32x32x16_bf16(pa2, PKV(v[4], v[5]), od, 0, 0, 0);
  od = __builtin_amdgcn_mfma_f32_32x32x16_bf16(pa3, PKV(v[6], v[7]), od, 0, 0, 0);
}
__device__ __forceinline__ void pv_d0(f32x16* o, int vb, bf16x8 pa0, bf16x8 pa1, bf16x8 pa2, bf16x8 pa3) {
  s16x4 va[8], vb_[8];
  pv_rd<0>(va, vb); pv_rd<1>(vb_, vb);
  asm volatile("s_waitcnt lgkmcnt(8)" ::: "memory"); SBAR(); pv_mm(o[0], va, pa0, pa1, pa2, pa3); SBAR();
  pv_rd<2>(va, vb);
  asm volatile("s_waitcnt lgkmcnt(8)" ::: "memory"); SBAR(); pv_mm(o[1], vb_, pa0, pa1, pa2, pa3); SBAR();
  pv_rd<3>(vb_, vb);
  asm volatile("s_waitcnt lgkmcnt(8)" ::: "memory"); SBAR(); pv_mm(o[2], va, pa0, pa1, pa2, pa3); SBAR();
  asm volatile("s_waitcnt lgkmcnt(0)" ::: "memory"); SBAR(); pv_mm(o[3], vb_, pa0, pa1, pa2, pa3);
}
#undef PKV

template <int c> __device__ __forceinline__ void map_epilogue(f32x16 (&o)[4], float l_reg, LAS float* li_l, float* stash, bf16* __restrict__ MIX, const float* __restrict__ subln_g, float lam,
                                                              int h, int i0, int tid, int wid, int r32, int hi) {
    if (hi == 0) li_l[r32] = l_reg; asm volatile("s_waitcnt lgkmcnt(0)" ::: "memory");
    float rli[16];
#pragma unroll
    for (int r = 0; r < 16; ++r) rli[r] = __builtin_amdgcn_rcpf(li_l[crow(r, hi)]);
    if (c == 0) {
#pragma unroll
      for (int d0 = 0; d0 < 4; ++d0)
#pragma unroll
        for (int r = 0; r < 16; ++r) ((GAS float*)stash)[(size_t)(d0 * 16 + r) * 512 + tid] = o[d0][r] * rli[r];
    } else {
#ifndef ATT_NOEPI
      float st[4][16];
#pragma unroll
      for (int d0 = 0; d0 < 4; ++d0)
#pragma unroll
        for (int r = 0; r < 16; ++r) st[d0][r] = __hip_atomic_load((GAS float*)stash + (size_t)(d0 * 16 + r) * 512 + tid, __ATOMIC_RELAXED, __HIP_MEMORY_SCOPE_AGENT);
      SBAR();
      float ssq[16];
#pragma unroll
      for (int r = 0; r < 16; ++r) { float s = 0.f;
#pragma unroll
        for (int d0 = 0; d0 < 4; ++d0) { const float v = st[d0][r] - lam * (o[d0][r] * rli[r]); o[d0][r] = v; s += v * v; }
        ssq[r] = s; }
#pragma unroll
      for (int r = 0; r < 16; ++r) {
#pragma unroll
        for (int x = 1; x < 32; x <<= 1) ssq[r] += __shfl_xor(ssq[r], x); }
      float sg[4];
#pragma unroll
      for (int d0 = 0; d0 < 4; ++d0) sg[d0] = ((const GAS float*)subln_g)[32 * d0 + r32] * (1.0f - LAM_INIT);
#pragma unroll
      for (int r = 0; r < 16; ++r) { const float rs = 1.0f / sqrtf(ssq[r] * (1.0f / 128.0f) + SUBLN_EPS);
        GAS bf16* orow = (GAS bf16*)MIX + (size_t)(i0 + wid * 32 + crow(r, hi)) * D + 2048 + h * 128 + r32;
#pragma unroll
        for (int d0 = 0; d0 < 4; ++d0) orow[32 * d0] = (bf16)(pk2(o[d0][r] * rs * sg[d0], 0.f) & 0xffffu); }
#endif
    }
}

template <int c> __device__ __forceinline__ void attn_map(LAS unsigned char* lds, const bf16* __restrict__ QKV, float* stash, bf16* __restrict__ MIX, const float* __restrict__ subln_g,
                                          int h, int i0, float lam, float sl2, int W) {
  int tid_ = threadIdx.x; asm volatile("" : "+v"(tid_));
  asm volatile("" : "+s"(QKV), "+s"(stash), "+s"(MIX), "+s"(subln_g), "+s"(h), "+s"(i0), "+s"(W));
  const int tid = tid_, wid = tid >> 6, lane = tid & 63, r32 = lane & 31, hi = lane >> 5;
  LAS unsigned char* V_lds = lds + V_OFF; LAS unsigned char* K_lds = lds + K_OFF;
  LAS float* ws = (LAS float*)(lds + WS_OFF) + wid * 64; LAS float* li_l = ws; LAS float* al_l = ws + 32;
  const int sr = tid >> 4, sc = (tid & 15) * 8, vst0 = v_st(sr, sc), vst1 = v_st(32 + sr, sc);
  const int kr = tid >> 3, kc = (tid & 7) * 8, kst = KSWZ64(kr, kc * 2);
  const int vb0 = (int)(unsigned)(uintptr_t)V_lds + v_rd_base(lane);
  const int qi = i0 + wid * 32 + r32; const float nsl2 = -sl2;
  int jlo = (i0 - W > 0 ? i0 - W : 0) >> 6, jhi = (i0 + 255 + W < T - 1 ? i0 + 255 + W : T - 1) >> 6;
  if (((jhi - jlo + 1) & 1) != 0) { if (jhi < T / KVBLK - 1) ++jhi; else --jlo; }
  const int NT = jhi - jlo + 1;
  {
    const bf16* Kh = QKV + 2048 + h * 128 + c * 64; const bf16* Vh = QKV + 4096 + h * 128;
    float m_reg = -1e30f, l_reg = 0; f32x16 o[4] = {}; bf16x8 qr[4];
    { const bf16* Qw = QKV + (size_t)qi * LDK + h * 128 + c * 64 + hi * 8;
#pragma unroll
      for (int d0 = 0; d0 < 4; ++d0) qr[d0] = *(const GAS bf16x8*)(Qw + d0 * 16); }
    struct { bf16x8 vs0, vs1, ks0; } sr_[2];
#define SLOAD(i, k0) do { sr_[i].vs0 = *(const GAS bf16x8*)(&Vh[(size_t)((k0) + sr) * LDK + sc]); sr_[i].vs1 = *(const GAS bf16x8*)(&Vh[(size_t)((k0) + 32 + sr) * LDK + sc]); \
    sr_[i].ks0 = *(const GAS bf16x8*)(&Kh[(size_t)((k0) + kr) * LDK + kc]); } while (0)
#define SWRITE(b, i) do { *(LAS bf16x8*)(V_lds + (b) * SHM_V + vst0) = sr_[i].vs0; *(LAS bf16x8*)(V_lds + (b) * SHM_V + vst1) = sr_[i].vs1; \
    *(LAS bf16x8*)(K_lds + (b) * SHM_K + kst) = sr_[i].ks0; } while (0)
#define SWAIT() asm volatile("s_waitcnt vmcnt(3)" ::: "memory")
#define RESC(a) do { if (__any((a) < 1.f)) { if (hi == 0) al_l[r32] = (a); asm volatile("s_waitcnt lgkmcnt(0)" ::: "memory"); \
    _Pragma("unroll") for (int d = 0; d < 4; ++d) _Pragma("unroll") for (int r = 0; r < 16; ++r) o[d][r] *= al_l[crow(r, hi)]; } } while (0)
#define TQ(tile) ((float)((jlo + (tile)) * KVBLK + 4 * hi - qi))
#define KOFF(tile) ((jlo + (tile)) * KVBLK)
    f32x16 pA0, pA1, pB0, pB1; float mnA, mnB, alA, alB; bf16x8 pa0, pa1, pa2, pa3;
    __syncthreads();
    SLOAD(0, KOFF(0)); asm volatile("s_waitcnt vmcnt(0)" ::: "memory"); SWRITE(0, 0); __syncthreads();
    qkt(pA0, pA1, K_lds, qr, r32, hi); partialSM(pA0, pA1, m_reg, mnA, alA, TQ(0), nsl2);
    SLOAD(1, KOFF(1)); SLOAD(0, KOFF(2));
    SWAIT(); SWRITE(1, 1); __syncthreads();
#pragma unroll 1
    for (int j = 1; j + 1 < NT; j += 2) {
      SBAR(); qkt(pB0, pB1, K_lds + SHM_K, qr, r32, hi);
      finishSM(pA0, pA1, alA, l_reg, pa0, pa1, pa2, pa3); SBAR();
      SLOAD(1, KOFF(j + 2)); SBAR();
      pv_d0(o, vb0, pa0, pa1, pa2, pa3); partialSM(pB0, pB1, m_reg, mnB, alB, TQ(j), nsl2);
      __syncthreads(); SWAIT(); SWRITE(0, 0);
      RESC(alB); __syncthreads();
      SBAR(); qkt(pA0, pA1, K_lds, qr, r32, hi);
      finishSM(pB0, pB1, alB, l_reg, pa0, pa1, pa2, pa3); SBAR();
      if (j + 3 < NT) SLOAD(0, KOFF(j + 3)); SBAR();
      pv_d0(o, vb0 + SHM_V, pa0, pa1, pa2, pa3); partialSM(pA0, pA1, m_reg, mnA, alA, TQ(j + 1), nsl2);
      __syncthreads(); SWAIT(); SWRITE(1, 1);
      RESC(alA); __syncthreads();
    }
    SBAR(); qkt(pB0, pB1, K_lds + SHM_K, qr, r32, hi);
    finishSM(pA0, pA1, alA, l_reg, pa0, pa1, pa2, pa3); SBAR();
    pv_d0(o, vb0, pa0, pa1, pa2, pa3); partialSM(pB0, pB1, m_reg, mnB, alB, TQ(NT - 1), nsl2);
    __syncthreads(); RESC(alB);
    finishSM(pB0, pB1, alB, l_reg, pa0, pa1, pa2, pa3); SBAR();
    pv_d0(o, vb0 + SHM_V, pa0, pa1, pa2, pa3);
    map_epilogue<c>(o, l_reg, li_l, stash, MIX, subln_g, lam, h, i0, tid, wid, r32, hi);
#undef SLOAD
#undef SWRITE
#undef SWAIT
#undef RESC
#undef TQ
#undef KOFF
  }
}
__device__ __forceinline__ unsigned bfbits(float x) { return pk2(x, 0.f) & 0xffffu; }
__device__ __forceinline__ void qkt_fast(f32x16& p0, f32x16& p1, const LAS unsigned char* Ks, const bf16x8* qr, int r32, int hi, bool aug, v4u ka0, v4u ka1, v4u qa) {
  p0 = f32x16{}; p1 = f32x16{};
#pragma unroll
  for (int d0 = 0; d0 < 4; ++d0) { const int cb = d0 * 32 + hi * 16;
    const bf16x8 b0 = *reinterpret_cast<const LAS bf16x8*>(Ks + KSWZ64(r32, cb));
    const bf16x8 b1 = *reinterpret_cast<const LAS bf16x8*>(Ks + KSWZ64(32 + r32, cb));
    p0 = __builtin_amdgcn_mfma_f32_32x32x16_bf16(b0, qr[d0], p0, 0, 0, 0);
    p1 = __builtin_amdgcn_mfma_f32_32x32x16_bf16(b1, qr[d0], p1, 0, 0, 0); }
  if (aug) {
    p0 = __builtin_amdgcn_mfma_f32_32x32x16_bf16(*reinterpret_cast<bf16x8*>(&ka0), *reinterpret_cast<bf16x8*>(&qa), p0, 0, 0, 0);
    p1 = __builtin_amdgcn_mfma_f32_32x32x16_bf16(*reinterpret_cast<bf16x8*>(&ka1), *reinterpret_cast<bf16x8*>(&qa), p1, 0, 0, 0); }
}
__device__ __forceinline__ void partialSM_fast(f32x16& p0, f32x16& p1, bool mixed, float tq, float nsl2, float nBref) {
  if (mixed) {
#pragma unroll
    for (int r = 0; r < 16; ++r) { const float d0 = tq + (float)((r & 3) + 8 * (r >> 2)); p0[r] = fmaf(fabsf(d0), nsl2, p0[r] + nBref); }
#pragma unroll
    for (int r = 0; r < 16; ++r) { const float d1 = tq + (float)(32 + (r & 3) + 8 * (r >> 2)); p1[r] = fmaf(fabsf(d1), nsl2, p1[r] + nBref); }
  }
#pragma unroll
  for (int r = 0; r < 16; ++r) p0[r] = __builtin_amdgcn_exp2f(p0[r]);
}
__device__ __forceinline__ void finishSM_fast(f32x16& p0, f32x16& p1, float& l_reg, bf16x8& pa0, bf16x8& pa1, bf16x8& pa2, bf16x8& pa3) {
#pragma unroll
  for (int r = 0; r < 16; ++r) p1[r] = __builtin_amdgcn_exp2f(p1[r]);
  float ps = 0;
#pragma unroll
  for (int r = 0; r < 16; ++r) ps += p0[r];
#pragma unroll
  for (int r = 0; r < 16; ++r) ps += p1[r];
  { auto rr = __builtin_amdgcn_permlane32_swap(__float_as_uint(ps), __float_as_uint(ps), false, false);
    ps = __uint_as_float(rr[0]) + __uint_as_float(rr[1]); }
  l_reg += ps;
#define PK4(P, BASE, OUT) do { unsigned a0 = pk2(P[BASE + 0], P[BASE + 1]), a1 = pk2(P[BASE + 2], P[BASE + 3]);   \
    unsigned b0 = pk2(P[BASE + 4], P[BASE + 5]), b1 = pk2(P[BASE + 6], P[BASE + 7]);                              \
    auto r0 = __builtin_amdgcn_permlane32_swap(a0, b0, false, false); auto r1 = __builtin_amdgcn_permlane32_swap(a1, b1, false, false); \
    v4u w = {r0[0], r1[0], r0[1], r1[1]}; OUT = *reinterpret_cast<bf16x8*>(&w); } while (0)
  PK4(p0, 0, pa0); PK4(p0, 8, pa1); PK4(p1, 0, pa2); PK4(p1, 8, pa3);
#undef PK4
}
constexpr int RING_SLOT = SHM_V + SHM_K, RING_NB = 4, FAST_WS_OFF = RING_NB * RING_SLOT;
template <int OFF> __device__ __forceinline__ bf16x8 lds_rd128(int addr) { bf16x8 r; asm volatile("ds_read_b128 %0, %1 offset:%2" : "=&v"(r) : "v"(addr), "i"(OFF) : "memory"); return r; }
template <int SLOT> __device__ __forceinline__ void qkt_ring2(f32x16& p0, f32x16& p1, const int (&kad)[4], const bf16x8* qr, bool aug, v4u ka0, v4u ka1, v4u qa) {
  constexpr int KB = SLOT * RING_SLOT + SHM_V;
  const int k0a = kad[0] + KB, k1a = kad[1] + KB, k2a = kad[2] + KB, k3a = kad[3] + KB;
  const bf16x8 a0 = lds_rd128<0>(k0a), b0 = lds_rd128<32 * 128>(k0a), a1 = lds_rd128<0>(k1a), b1 = lds_rd128<32 * 128>(k1a);
  const bf16x8 a2 = lds_rd128<0>(k2a), b2 = lds_rd128<32 * 128>(k2a), a3 = lds_rd128<0>(k3a), b3 = lds_rd128<32 * 128>(k3a);
  p0 = f32x16{}; p1 = f32x16{};
  asm volatile("s_waitcnt lgkmcnt(0)" ::: "memory"); SBAR();
  p0 = __builtin_amdgcn_mfma_f32_32x32x16_bf16(a0, qr[0], p0, 0, 0, 0); p1 = __builtin_amdgcn_mfma_f32_32x32x16_bf16(b0, qr[0], p1, 0, 0, 0);
  p0 = __builtin_amdgcn_mfma_f32_32x32x16_bf16(a1, qr[1], p0, 0, 0, 0); p1 = __builtin_amdgcn_mfma_f32_32x32x16_bf16(b1, qr[1], p1, 0, 0, 0);
  p0 = __builtin_amdgcn_mfma_f32_32x32x16_bf16(a2, qr[2], p0, 0, 0, 0); p1 = __builtin_amdgcn_mfma_f32_32x32x16_bf16(b2, qr[2], p1, 0, 0, 0);
  p0 = __builtin_amdgcn_mfma_f32_32x32x16_bf16(a3, qr[3], p0, 0, 0, 0); p1 = __builtin_amdgcn_mfma_f32_32x32x16_bf16(b3, qr[3], p1, 0, 0, 0);
  if (aug) {
    p0 = __builtin_amdgcn_mfma_f32_32x32x16_bf16(*reinterpret_cast<bf16x8*>(&ka0), *reinterpret_cast<bf16x8*>(&qa), p0, 0, 0, 0);
    p1 = __builtin_amdgcn_mfma_f32_32x32x16_bf16(*reinterpret_cast<bf16x8*>(&ka1), *reinterpret_cast<bf16x8*>(&qa), p1, 0, 0, 0); }
}
template <int c, int VAR> __device__ __forceinline__ void attn_map_fast(LAS unsigned char* lds, const bf16* __restrict__ QKV, float* stash, bf16* __restrict__ MIX, const float* __restrict__ subln_g,
                                               int h, int i0, float lam, float sl2, int W, float Bref) {
  int tid_ = threadIdx.x; asm volatile("" : "+v"(tid_));
  asm volatile("" : "+s"(QKV), "+s"(stash), "+s"(MIX), "+s"(subln_g), "+s"(h), "+s"(i0), "+s"(W));
  const int tid = tid_, wid = tid >> 6, lane = tid & 63, r32 = lane & 31, hi = lane >> 5;
  const int wave_u = __builtin_amdgcn_readfirstlane(wid);
  LAS float* li_l = (LAS float*)(lds + FAST_WS_OFF) + wid * 64;
  const int lds0 = (int)(unsigned)(uintptr_t)lds;
  const int vb0 = lds0 + v_rd_base(lane);
  int kad[4];
#pragma unroll
  for (int d0 = 0; d0 < 4; ++d0) kad[d0] = lds0 + KSWZ64(r32, d0 * 32 + hi * 16);
  int goK, goV0, goV1;
  { const int row = tid >> 3, lc = (tid & 7) ^ ((row >> 1) & 7); goK = row * LDK + lc * 8; }
#define VSRC(L, OUT) do { const int sub_ = (L) >> 5, rem_ = (L) & 31, kk_ = ((sub_ >> 2) << 3) | (rem_ >> 2), cc_ = ((sub_ & 3) << 5) | ((rem_ & 3) << 3); \
    const int k_ = (kk_ & ~0xC) | ((kk_ & 4) << 1) | ((kk_ & 8) >> 1); OUT = k_ * LDK + cc_; } while (0)
  VSRC(tid, goV0); VSRC(512 + tid, goV1);
#undef VSRC
  const int iw = i0 + wave_u * 32, qi = iw + r32; const float nsl2 = -sl2, nBref = -Bref;
  int jlo = (i0 - W > 0 ? i0 - W : 0) >> 6, jhi = (i0 + 255 + W < T - 1 ? i0 + 255 + W : T - 1) >> 6;
  while (((jhi - jlo + 1) & 3) != 0) { if (jhi < T / KVBLK - 1) ++jhi; else --jlo; }
  const int NT = jhi - jlo + 1;
  const float s1f = __uint_as_float(bfbits(sl2) << 16), s2f = __uint_as_float(bfbits(sl2 - s1f) << 16), s3f = __uint_as_float(bfbits(sl2 - s1f - s2f) << 16);
  const unsigned S1 = bfbits(s1f), S2 = bfbits(s2f), S3 = bfbits(s3f), II = bfbits((float)r32), J0 = bfbits((float)r32), J1 = bfbits((float)(32 + r32)), ONE = 0x3f80u, NEG = 0x8000u;
  v4u qa = hi ? (v4u){0u, 0u, 0u, 0u} : (v4u){S1 | (S2 << 16), S3 | (II << 16), II | (II << 16), 0u};
  v4u ka0 = hi ? (v4u){ONE, 0u, 0u, 0u} : (v4u){J0 | (J0 << 16), J0 | ((S1 ^ NEG) << 16), (S2 ^ NEG) | ((S3 ^ NEG) << 16), ONE | (ONE << 16)};
  v4u ka1 = hi ? (v4u){ONE, 0u, 0u, 0u} : (v4u){J1 | (J1 << 16), J1 | ((S1 ^ NEG) << 16), (S2 ^ NEG) | ((S3 ^ NEG) << 16), ONE | (ONE << 16)};
  const unsigned flipm = hi ? 0u : 0x80008000u;
  bool right_signs = false;
#define TILE_SETUP(tile, MIXED) do { const int k0_ = (jlo + (tile)) * KVBLK; const bool left_ = k0_ + 63 <= iw, right_ = k0_ >= iw + 31; MIXED = !(left_ || right_); \
    if (right_ && !right_signs) { right_signs = true; ka0.x ^= flipm; ka0.y ^= flipm; ka0.z ^= flipm; ka1.x ^= flipm; ka1.y ^= flipm; ka1.z ^= flipm; } \
    const int dd_ = iw - k0_; const float c_ = nsl2 * (float)(dd_ < 0 ? -dd_ : dd_) + nBref; \
    const unsigned w1_ = bfbits(c_); const float r1_ = c_ - __uint_as_float(w1_ << 16); const unsigned w2_ = bfbits(r1_); const float r2_ = r1_ - __uint_as_float(w2_ << 16); const unsigned w3_ = bfbits(r2_); \
    if (hi) qa.x = w3_; else qa.w = w1_ | (w2_ << 16); } while (0)
  {
    const bf16* Kh = QKV + 2048 + h * 128 + c * 64; const bf16* Vh = QKV + 4096 + h * 128;
    float l_reg = 0; f32x16 o[4] = {}; bf16x8 qr[4];
    { const bf16* Qw = QKV + (size_t)qi * LDK + h * 128 + c * 64 + hi * 8;
#pragma unroll
      for (int d0 = 0; d0 < 4; ++d0) qr[d0] = *(const GAS bf16x8*)(Qw + d0 * 16); }
#define DMA(tile, SLOT) do { if (VAR & 8) break; const int tt_ = (tile) < NT ? (tile) : NT - 1; const size_t kb_ = (size_t)((jlo + tt_) * KVBLK) * LDK; \
    __builtin_amdgcn_global_load_lds((const unsigned*)(Vh + kb_ + goV0), (LAS unsigned*)(lds + (SLOT) * RING_SLOT + wave_u * 1024), 16, 0, 0); \
    __builtin_amdgcn_global_load_lds((const unsigned*)(Vh + kb_ + goV1), (LAS unsigned*)(lds + (SLOT) * RING_SLOT + 8192 + wave_u * 1024), 16, 0, 0); \
    __builtin_amdgcn_global_load_lds((const unsigned*)(Kh + kb_ + goK), (LAS unsigned*)(lds + (SLOT) * RING_SLOT + SHM_V + wave_u * 1024), 16, 0, 0); } while (0)
#define RBAR() do { if (VAR & 16) break; asm volatile("s_waitcnt vmcnt(3)" ::: "memory"); __builtin_amdgcn_s_barrier(); asm volatile("" ::: "memory"); } while (0)
#define TQ(tile) ((float)((jlo + (tile)) * KVBLK + 4 * hi - qi))
    f32x16 pA0 = {}, pA1 = {}, pB0 = {}, pB1 = {}; bf16x8 pa0 = {}, pa1 = {}, pa2 = {}, pa3 = {}; bool mx; const bool lead = wave_u < 4;
    asm volatile("s_waitcnt vmcnt(0)" ::: "memory");
    __syncthreads();
    DMA(0, 0); DMA(1, 1); DMA(2, 2);
    asm volatile("s_waitcnt vmcnt(6)" ::: "memory"); __builtin_amdgcn_s_barrier(); asm volatile("" ::: "memory");
#define TSTEP_A(tt, SLOT, PREV, PC0, PC1, PP0, PP1, HASPREV) do { \
        TILE_SETUP(tt, mx); \
        if (!(VAR & 4)) qkt_ring2<SLOT>(PC0, PC1, kad, qr, !mx, ka0, ka1, qa); \
        if (HASPREV) { if (!(VAR & 2)) finishSM_fast(PP0, PP1, l_reg, pa0, pa1, pa2, pa3); SBAR(); if (!(VAR & 1)) pv_d0(o, vb0 + (PREV) * RING_SLOT, pa0, pa1, pa2, pa3); } \
        if (!(VAR & 2)) partialSM_fast(PC0, PC1, mx, TQ(tt), nsl2, nBref); } while (0)
#define TSTEP_B(tt, SLOT, PREV, PC0, PC1, PP0, PP1, HASPREV) do { \
        TILE_SETUP(tt, mx); \
        if (HASPREV) { if (!(VAR & 2)) finishSM_fast(PP0, PP1, l_reg, pa0, pa1, pa2, pa3); SBAR(); } \
        if (!(VAR & 4)) qkt_ring2<SLOT>(PC0, PC1, kad, qr, !mx, ka0, ka1, qa); \
        if (!(VAR & 2)) partialSM_fast(PC0, PC1, mx, TQ(tt), nsl2, nBref); SBAR(); \
        if (HASPREV) { if (!(VAR & 1)) pv_d0(o, vb0 + (PREV) * RING_SLOT, pa0, pa1, pa2, pa3); } } while (0)
#define TLOOP(TS) _Pragma("unroll 1") for (int t = 0; t < NT; t += 4) { \
      TS(t, 0, 3, pA0, pA1, pB0, pB1, t > 0);      RBAR(); DMA(t + 3, 3); \
      TS(t + 1, 1, 0, pB0, pB1, pA0, pA1, true);   RBAR(); DMA(t + 4, 0); \
      TS(t + 2, 2, 1, pA0, pA1, pB0, pB1, true);   RBAR(); DMA(t + 5, 1); \
      TS(t + 3, 3, 2, pB0, pB1, pA0, pA1, true);   RBAR(); DMA(t + 6, 2); }
    if (lead) { TLOOP(TSTEP_A) } else { TLOOP(TSTEP_B) }
#undef TSTEP_A
#undef TSTEP_B
#undef TLOOP
    finishSM_fast(pB0, pB1, l_reg, pa0, pa1, pa2, pa3); SBAR(); pv_d0(o, vb0 + 3 * RING_SLOT, pa0, pa1, pa2, pa3);
    asm volatile("s_waitcnt vmcnt(0)" ::: "memory");
    map_epilogue<c>(o, l_reg, li_l, stash, MIX, subln_g, lam, h, i0, tid, wid, r32, hi);
#undef DMA
#undef RBAR
#undef TQ
#undef TILE_SETUP
  }
}
template <int VAR> __device__ __forceinline__ void attn_unit(LAS unsigned char* lds, const bf16* __restrict__ QKV, float* stash, bf16* __restrict__ MIX, const float* __restrict__ subln_g,
                                          int h, int i0, float lam, float sl2, float qn2a, float kn2a, float qn2b, float kn2b) {
  const float Ba = sqrtf(qn2a * kn2a) * 1.0001f + 0.01f, Bb = sqrtf(qn2b * kn2b) * 1.0001f + 0.01f;
  const bool fa = __builtin_amdgcn_readfirstlane((int)(2.0f * Ba < 100.0f)) != 0, fb = __builtin_amdgcn_readfirstlane((int)(2.0f * Bb < 100.0f)) != 0;
  const float wa = (fa ? 134.0f : 2.0f * Ba + THR2 + 134.0f) / sl2, wb = (fb ? 134.0f : 2.0f * Bb + THR2 + 134.0f) / sl2;
  const int W0 = __builtin_amdgcn_readfirstlane(wa < 16384.0f ? (int)wa + 1 : 16384), W1 = __builtin_amdgcn_readfirstlane(wb < 16384.0f ? (int)wb + 1 : 16384);
  if (fa) attn_map_fast<0, VAR>(lds, QKV, stash, MIX, subln_g, h, i0, lam, sl2, W0, Ba); else attn_map<0>(lds, QKV, stash, MIX, subln_g, h, i0, lam, sl2, W0);
  if (fb) attn_map_fast<1, VAR>(lds, QKV, stash, MIX, subln_g, h, i0, lam, sl2, W1, Bb); else attn_map<1>(lds, QKV, stash, MIX, subln_g, h, i0, lam, sl2, W1);
}
}

namespace scan {
constexpr int CH = 16, NCH = T / CH;
constexpr int VEC_OFF = 0, VEC_BYTES = CH * 5 * 64 * 4;
constexpr int VV_OFF = 2 * VEC_BYTES, VV_BYTES = CH * 32 * 4;
constexpr int YP_OFF = VV_OFF + 2 * VV_BYTES, YP_BYTES = CH * 512 * 4;
constexpr int SCAN_LDS = YP_OFF + 2 * YP_BYTES;
struct ConvJob { const float* wg; const float* wu; const float* wd; bf16* WGU2; bf16* WD2; int wave_gid, n_waves; };
constexpr int CV_GATE = (D / 64) * (FF / 32), CV_DOWN = (FF / 64) * (D / 32), CV_ITEMS = 2 * CV_GATE + CV_DOWN;
constexpr int CV_SCR_OFF = 110592, CV_SCR_BYTES = 64 * 33 * 4;
static_assert(TAIL_GU <= CV_GATE && TAIL_WD2 < CV_DOWN, "tail splits");
struct Tensors { const bf16* R; const bf16* K; const bf16* KK; const bf16* V; const float* DEC[2]; const float* A[2]; const float* k_a; float* Y[2]; const float* r_k; float* BON[2]; };

template <int var> __device__ __forceinline__ void scan_unit(LAS unsigned char* lds, const Tensors& P, const ConvJob& CJ, int h, int dir, int rg, float* dummy) {
    int tid_ = threadIdx.x; asm volatile("" : "+v"(tid_));
    const int tid = tid_, wave = __builtin_amdgcn_readfirstlane(tid >> 6), lane = tid & 63;
    const float* DEC = dir ? P.DEC[1] : P.DEC[0]; const float* AA = dir ? P.A[1] : P.A[0]; float* Y = dir ? P.Y[1] : P.Y[0]; float* BON = dir ? P.BON[1] : P.BON[0]; if (var & 1) { Y = dummy; BON = dummy; }
    const int chan0 = h * 64, row0 = chan0 + 32 * rg;
    const int hw = wave - 4;
#define DECLSET(n) v2u k##n, kk##n, r##n, v##n; f32x4 w##n, a##n
    DECLSET(0); DECLSET(1); DECLSET(2); DECLSET(3);
    const int hi_ = lane >> 4, hq = lane & 15;
    f32x4 kav = *(const GAS f32x4*)(P.k_a + chan0 + 4 * hq), rkv = *(const GAS f32x4*)(P.r_k + chan0 + 4 * hq);
    asm volatile("" : "+v"(kav), "+v"(rkv));
#define TSTEP(step) (dir ? (T - 1 - (step)) : (step))
#define HLOAD(n, chunk) do { const int t_ = TSTEP((chunk) * CH + hw * 4 + hi_); const size_t ix = (size_t)t_ * DR + chan0 + 4 * hq; \
        k##n = *(const GAS v2u*)(P.K + ix); kk##n = *(const GAS v2u*)(P.KK + ix); r##n = *(const GAS v2u*)(P.R + ix); w##n = *(const GAS f32x4*)(DEC + ix); a##n = *(const GAS f32x4*)(AA + ix); \
        v##n = *(const GAS v2u*)(P.V + (size_t)t_ * DR + row0 + 4 * (hq & 7)); } while (0)
#define HSTAGE(n, buf, chunk) do { LAS f32x4* vp = (LAS f32x4*)(lds + VEC_OFF + (buf) * VEC_BYTES) + (hw * 4 + hi_) * 80 + hq; const f32x4 kkf_ = bf4_to_f32(kk##n); \
        const f32x4 kd_ = bf4_to_f32(k##n) * (1.0f + (a##n - 1.0f) * kav), rf_ = bf4_to_f32(r##n); \
        vp[0] = -kkf_; vp[16] = w##n; vp[32] = kkf_ * a##n; vp[48] = kd_; vp[64] = rf_; \
        if (hq < 8) ((LAS f32x4*)(lds + VV_OFF + (buf) * VV_BYTES))[(hw * 4 + hi_) * 8 + hq] = bf4_to_f32(v##n); \
          \
        const float bs_ = row16_sum(dot4(rf_ * kd_, rkv)); \
        if (hq == 0) BON[(size_t)TSTEP(((chunk) < NCH ? (chunk) : NCH - 1) * CH + hw * 4 + hi_) * NHR + h] = bs_; } while (0)
#define HREDUCE1(buf, chunk, oi) do { const int s_ = (oi) >> 5, rr_ = (oi) & 31; \
        const LAS f32x4* yp = (const LAS f32x4*)(lds + YP_OFF + (buf) * YP_BYTES) + s_ * 128 + (rr_ >> 3) * 32 + ((rr_ >> 2) & 1) * 16 + (rr_ & 3) * 4; \
        const f32x4 a_ = yp[0], b_ = yp[1], c_ = yp[2], d_ = yp[3]; const f32x4 e_ = (a_ + b_) + (c_ + d_); \
        Y[(size_t)TSTEP((chunk) * CH + s_) * DR + row0 + rr_] = (e_.x + e_.y) + (e_.z + e_.w); } while (0)
#define HREDUCE(buf, chunk) do { HREDUCE1(buf, chunk, hw * 64 + lane); HREDUCE1(buf, chunk, hw * 64 + lane + 256); } while (0)
    const int q = lane & 15, rw = lane >> 4;
    f32x2 A01 = {0.f, 0.f}, A23 = {0.f, 0.f}, B01 = {0.f, 0.f}, B23 = {0.f, 0.f};
    f32x4 cva[8], cvb[8]; int cv_it = CJ.wave_gid;
    int cva_it = CV_ITEMS, cvb_it = CV_ITEMS;
    LAS float* cscr = (LAS float*)(lds + CV_SCR_OFF + hw * CV_SCR_BYTES);
#define CV_DECODE(it, W_, N_, K_, WT_, k0_, n0_, dr_) do { int r_ = (it); if (r_ < 2 * CV_GATE) { const bool up_ = r_ >= CV_GATE; if (up_) r_ -= CV_GATE; W_ = up_ ? CJ.wu : CJ.wg; N_ = FF; K_ = D; WT_ = CJ.WGU2; \
        const int kb_ = r_ / (FF / 32), nb_ = r_ - kb_ * (FF / 32); k0_ = 64 * kb_; n0_ = 32 * nb_; dr_ = 256 * (n0_ >> 7) + (up_ ? 128 : 0) + (n0_ & 127); } \
      else { r_ -= 2 * CV_GATE; W_ = CJ.wd; N_ = D; K_ = FF; WT_ = CJ.WD2; const int kb_ = r_ / (D / 32), nb_ = r_ - kb_ * (D / 32); k0_ = 64 * kb_; n0_ = 32 * nb_; dr_ = n0_; } } while (0)
#define CV_LOAD(REG, HELD) do { HELD = cv_it; if (cv_it < CV_ITEMS) { const float* W_; int N_, K_, k0_, n0_, dr_; bf16* WT_; CV_DECODE(cv_it, W_, N_, K_, WT_, k0_, n0_, dr_); (void)K_; (void)WT_; (void)dr_; \
        const float* src_ = W_ + (size_t)(k0_ + (lane >> 3)) * N_ + n0_ + 4 * (lane & 7); \
        _Pragma("unroll") for (int i = 0; i < 8; ++i) REG[i] = *(const GAS f32x4*)(src_ + (size_t)(8 * i) * N_); \
        const int nx_ = cv_it + CJ.n_waves; cv_it = (cv_it < 2 * CV_GATE && nx_ >= 2 * CV_GATE) ? nx_ + TAIL_WD2 : nx_; } } while (0)
#define CV_STORE(REG, HELD) do { if (HELD < CV_ITEMS) { const float* W_; int N_, K_, k0_, n0_, dr_; bf16* WT_; CV_DECODE(HELD, W_, N_, K_, WT_, k0_, n0_, dr_); (void)W_; (void)N_; \
        _Pragma("unroll") for (int i = 0; i < 8; ++i) { LAS float* d_ = cscr + (8 * i + (lane >> 3)) * 33 + 4 * (lane & 7); d_[0] = REG[i].x; d_[1] = REG[i].y; d_[2] = REG[i].z; d_[3] = REG[i].w; } \
        asm volatile("s_waitcnt lgkmcnt(0)" ::: "memory"); \
        _Pragma("unroll") for (int j = 0; j < 4; ++j) { const int n_ = (lane >> 3) + 8 * j; const LAS float* s_ = cscr + (8 * (lane & 7)) * 33 + n_; \
            v4u o_; o_.x = pk2(s_[0 * 33], s_[1 * 33]); o_.y = pk2(s_[2 * 33], s_[3 * 33]); o_.z = pk2(s_[4 * 33], s_[5 * 33]); o_.w = pk2(s_[6 * 33], s_[7 * 33]); \
            *(GAS v4u*)(WT_ + (size_t)(dr_ + n_) * K_ + k0_ + 8 * (lane & 7)) = o_; } \
        asm volatile("s_waitcnt lgkmcnt(0)" ::: "memory"); HELD = CV_ITEMS; } } while (0)
#define CHUNK_BAR() do { asm volatile("s_waitcnt lgkmcnt(0)" ::: "memory"); __builtin_amdgcn_s_barrier(); asm volatile("" ::: "memory"); } while (0)
#define CHUNK_SCAN(c, BUF) do { if (!(var & 16)) { \
            const LAS f32x4* vec = (const LAS f32x4*)(lds + VEC_OFF + (BUF) * VEC_BYTES) + q; \
            const LAS float* vv = (const LAS float*)(lds + VV_OFF + (BUF) * VV_BYTES) + 8 * (wave & 3) + rw; \
            LAS float* ypw = (LAS float*)(lds + YP_OFF + (BUF) * YP_BYTES) + (wave & 3) * 128 + lane; \
            f32x4 VS[4][5]; float VA[4], VB[4];                     \
            _Pragma("unroll") for (int p = 0; p < 3; ++p) { _Pragma("unroll") for (int e = 0; e < 5; ++e) VS[p][e] = vec[p * 80 + e * 16]; VA[p] = vv[p * 32]; VB[p] = vv[p * 32 + 4]; } \
            _Pragma("unroll") for (int s = 0; s < CH; ++s) { \
                if (s + 3 < CH) { _Pragma("unroll") for (int e = 0; e < 5; ++e) VS[(s + 3) & 3][e] = vec[(s + 3) * 80 + e * 16]; VA[(s + 3) & 3] = vv[(s + 3) * 32]; VB[(s + 3) & 3] = vv[(s + 3) * 32 + 4]; } \
                const f32x4 nkk4 = VS[s & 3][0], w4 = VS[s & 3][1], b4 = VS[s & 3][2], kd4 = VS[s & 3][3], r4 = VS[s & 3][4]; const float va = VA[s & 3], vb = VB[s & 3]; \
                const f32x2 n01 = {nkk4.x, nkk4.y}, n23 = {nkk4.z, nkk4.w}, w01 = {w4.x, w4.y}, w23 = {w4.z, w4.w}, b01 = {b4.x, b4.y}, b23 = {b4.z, b4.w}, k01 = {kd4.x, kd4.y}, k23 = {kd4.z, kd4.w}, r01 = {r4.x, r4.y}, r23 = {r4.z, r4.w}; \
                const f32x2 ppa = A01 * n01 + A23 * n23, ppb = B01 * n01 + B23 * n23; \
                const float saa = row16_sum(ppa.x + ppa.y), sab = row16_sum(ppb.x + ppb.y); \
                const f32x2 sa2 = {saa, saa}, sb2 = {sab, sab}, va2 = {va, va}, vb2 = {vb, vb}; \
                A01 = A01 * w01 + (sa2 * b01 + va2 * k01); A23 = A23 * w23 + (sa2 * b23 + va2 * k23); \
                B01 = B01 * w01 + (sb2 * b01 + vb2 * k01); B23 = B23 * w23 + (sb2 * b23 + vb2 * k23); \
                const f32x2 ya = A01 * r01 + A23 * r23, yb = B01 * r01 + B23 * r23; \
                if (!(var & 8)) { ypw[s * 512] = ya.x + ya.y; ypw[s * 512 + 64] = yb.x + yb.y; } \
            } } \
        CHUNK_BAR(); } while (0)
#define CHUNK_HELP(c, BUF, ST, LD, CONV) do { if (!(var & 32)) { \
            if (!(var & 4)) { HLOAD(LD, ((c) + 4 < NCH ? (c) + 4 : NCH - 1));         \
            HSTAGE(ST, (BUF) ^ 1, (c) + 1); }                                 \
            if (!(var & 2)) HREDUCE((BUF) ^ 1, ((c) >= 1 ? (c) - 1 : 0)); CONV;            \
        } \
        CHUNK_BAR(); } while (0)
    __syncthreads();
    if (wave >= 4) { HLOAD(0, 0); HLOAD(1, 1); HLOAD(2, 2); HLOAD(3, 3); HSTAGE(0, 0, 0); }
    __syncthreads();
    if (wave < 4 || (var & 64)) {
#pragma unroll 1
        for (int c = 0; c < NCH; c += 4) { CHUNK_SCAN(c, 0); CHUNK_SCAN(c + 1, 1); CHUNK_SCAN(c + 2, 0); CHUNK_SCAN(c + 3, 1); }
    } else {
#pragma unroll 1
        for (int c = 0; c < NCH; c += 4) {
            CHUNK_HELP(c, 0, 1, 0, CV_LOAD(cva, cva_it)); CHUNK_HELP(c + 1, 1, 2, 1, CV_LOAD(cvb, cvb_it)); CHUNK_HELP(c + 2, 0, 3, 2, CV_STORE(cva, cva_it)); CHUNK_HELP(c + 3, 1, 0, 3, CV_STORE(cvb, cvb_it)); }
    }
    if (wave >= 4) HREDUCE((NCH - 1) & 1, NCH - 1);
    asm volatile("s_waitcnt vmcnt(0)" ::: "memory");
#undef TSTEP
#undef HLOAD
#undef HSTAGE
#undef HREDUCE
#undef HREDUCE1
#undef CHUNK_SCAN
#undef CHUNK_HELP
#undef CHUNK_BAR
#undef CV_DECODE
#undef CV_LOAD
#undef CV_STORE
#undef DECLSET
}
}

enum { I_X = 0, I_F1_PRE, I_F1_WG, I_F1_WU, I_F1_WD, I_F1_POST, I_MIX_PRE, I_WIN, I_MU_PREV, I_MU_NEXT, I_W0F, I_W2F, I_W0B, I_W2B, I_A0F, I_A2F, I_A0B, I_A2B, I_G2, I_KK, I_KA, I_RK, I_GNW, I_GNB,
       I_LQ1, I_LK1, I_LQ2, I_LK2, I_SUBLN, I_WOUT, I_MIX_POST, I_F2_PRE, I_F2_WG, I_F2_WU, I_F2_WD, I_F2_POST, I_FINAL, N_IN };
constexpr int NORM_W = 32768, QCTR_W = 32768 + 128;
struct Args { const float* in[N_IN]; float* out; unsigned char* ws; int ph_lo, ph_hi, li, pad; };
static_assert(sizeof(Args) == (N_IN + 2) * 8 + 16, "Args has no padding");

__global__ void __launch_bounds__(NWAVES * 64, 2) hyb_fwd(Args args) {
    extern __shared__ __attribute__((aligned(16))) unsigned char lds_raw[];
    LAS unsigned char* lds = (LAS unsigned char*)lds_raw;
    volatile LAS unsigned* MISC = (volatile LAS unsigned*)(lds + MISC_OFF);
    const int tid0 = threadIdx.x;
    const int G = gridDim.x, bx = blockIdx.x, vcu = (G % 8 == 0) ? (bx % 8) * (G / 8) + bx / 8 : bx;
    const int NGW = G * NWAVES;
#define PHASE_IDS() int tid = threadIdx.x; asm volatile("" : "+v"(tid)); const int lane = tid & 63, wave = __builtin_amdgcn_readfirstlane(tid >> 6), gw = vcu * NWAVES + wave; (void)lane; (void)gw; \
    LAS float* const scr = (LAS float*)(lds + RING_OFF + wave * 16384); (void)scr
    unsigned char* ws = args.ws;
    for (int u = tid0; u < (LDS_BYTES - LDSCTL_OFF) / 4; u += NWAVES * 64) ((LAS unsigned*)(lds + LDSCTL_OFF))[u] = 0u;
    __syncthreads();
    const int lo = args.ph_lo, hi = args.ph_hi;
    unsigned* const barw = (unsigned*)(ws + WS_CTL) + 1024 + args.li * 4096;
    XcdBarrier bar; bar.bar = barw; bar.x = 0; bar.st = nullptr;
    if (hi - lo > 1) bar = xcd_barrier_post(barw, MISC + 8);
#if defined(PHASE_MASK)
#define IN(k) (((PHASE_MASK >> (k)) & 1) && lo <= (k) && (k) < hi)
#elif defined(ONLY_PHASE)
#define IN(k) ((k) == ONLY_PHASE && lo <= (k) && (k) < hi)
#else
#define IN(k) (lo <= (k) && (k) < hi)
#endif
#define SEAM(k) do { if (IN(k) && IN((k) + 1)) xcd_barrier(bar); } while (0)
    bf16* const WGU = (bf16*)(ws + WS_WGU); bf16* const WD = (bf16*)(ws + WS_WD); bf16* const WIN = (bf16*)(ws + WS_WIN); bf16* const WOUT = (bf16*)(ws + WS_WOUT);
    bf16* const WGU2 = (bf16*)(ws + WS_WGU2); bf16* const WD2 = (bf16*)(ws + WS_WD2);
    bf16* const W2T = (bf16*)(ws + WS_W2T); bf16* const A2T = (bf16*)(ws + WS_A2T); bf16* const G2T = (bf16*)(ws + WS_G2T);
    bf16* const XN = (bf16*)(ws + WS_XN); bf16* const HID = (bf16*)(ws + WS_HID); bf16* const Fb = (bf16*)(ws + WS_F); bf16* const Hb = (bf16*)(ws + WS_H);
    bf16* const PR = (bf16*)(ws + WS_PR); bf16* const QKV = (bf16*)(ws + WS_QKV);
    bf16* const Rb = (bf16*)(ws + WS_R); bf16* const Kb = (bf16*)(ws + WS_K); bf16* const Vb = (bf16*)(ws + WS_V); bf16* const KKb = (bf16*)(ws + WS_KK);
    bf16* const HWb = (bf16*)(ws + WS_HW); bf16* const XAb = (bf16*)(ws + WS_XA); bf16* const SGb = (bf16*)(ws + WS_SG);
    float* const DECF = (float*)(ws + WS_DECF); float* const DECB = (float*)(ws + WS_DECB); float* const AFb = (float*)(ws + WS_AF); float* const ABb = (float*)(ws + WS_AB); bf16* const Gb = (bf16*)(ws + WS_G);
    float* const BONF = (float*)(ws + WS_BONF); float* const BONB = (float*)(ws + WS_BONB);
    float* const YF = (float*)(ws + WS_YF); float* const YB = (float*)(ws + WS_YB); float* const O1 = (float*)(ws + WS_O1);

    if (IN(0)) { PHASE_IDS();
        conv_mat<1>(args.in[I_F1_WG], D, FF, WGU, scr, gw, NGW, lane);
        conv_mat<2>(args.in[I_F1_WU], D, FF, WGU, scr, gw, NGW, lane);
        conv_mat<0>(args.in[I_F1_WD], FF, D, WD, scr, gw, NGW, lane, G == 256 ? TAIL_WD : 0);
        conv_mat<3>(args.in[I_WIN], D, 12736, WIN, scr, gw, NGW, lane);
        if (G != 256) conv_mat<0>(args.in[I_WOUT], D, D, WOUT, scr, gw, NGW, lane);
        conv_mat<0>(args.in[I_G2], LK, DR, G2T, scr, gw, NGW, lane);
        conv_lora96(args.in[I_W2F], args.in[I_W2B], W2T, vcu * 512 + tid, G * 512);
        conv_lora96(args.in[I_A2F], args.in[I_A2B], A2T, vcu * 512 + tid, G * 512);
        for (int i = vcu * 512 + tid; i < 64 * 4096 / 8; i += G * 512) *(GAS v4u*)(WIN + (size_t)RC * D + (size_t)i * 8) = (v4u){0u, 0u, 0u, 0u};
        xn_phase(lds + RING_OFF, args.in[I_X], args.in[I_F1_PRE], XN, gw, NGW, tid, lane);
    }
    SEAM(0);
    if (IN(1)) { PHASE_IDS(); __syncthreads();
        pg8::Gemm g{XN, WGU, T, 2 * FF, D}; pg8::StaticOrder S; S.init(T, 2 * FF, G, bx); pg8::EpiSwiGLU E{HID, FF};
        pg8::gemm_phase<pg8::EpiSwiGLU, pg8::StaticOrder, true, true>(lds + RING_OFF, g, S, E);
        if (G == 256 && bx >= 192) { __syncthreads(); conv_mat<0>(args.in[I_F1_WD], FF, D, WD, scr, (bx - 192) * NWAVES + wave, 64 * NWAVES, lane, 0, TAIL_WD); } }
    SEAM(1);
    if (IN(2)) { PHASE_IDS(); __syncthreads();
        pg8::Gemm g{HID, WD, T, D, FF}; pg8::StaticOrder S; S.init(T, D, G, bx); pg8::EpiBf16Out E{Fb, D};
        pg8::gemm_phase<pg8::EpiBf16Out, pg8::StaticOrder, true, true>(lds + RING_OFF, g, S, E); }
    SEAM(2);
    if (IN(3)) { PHASE_IDS();
        rr_phase<false, true>(lds + RING_OFF, Fb, args.in[I_X], 0.5f, args.in[I_F1_POST], args.in[I_MIX_PRE], Hb, XN, nullptr, gw, NGW, tid, lane); }
    SEAM(3);
    if (IN(4)) { PHASE_IDS(); __syncthreads();
        pg8::Gemm g{XN, WIN, T, NIN, D}; pg8::StaticOrder S; S.init(T, NIN, G, bx); pg8::EpiIn E{PR, QKV, QSCALE};
        pg8::gemm_phase<pg8::EpiIn, pg8::StaticOrder, true, true>(lds + RING_OFF, g, S, E);
        if (G == 256 && bx >= 64) { __syncthreads(); const int tg = (bx - 64) * NWAVES + wave, tn = 192 * NWAVES;
            conv_mat<0>(args.in[I_WOUT], D, D, WOUT, scr, tg, tn, lane);
            conv_mat<1>(args.in[I_F2_WG], D, FF, WGU2, scr, tg, tn, lane, 0, TAIL_GU); } }
    SEAM(4);
    if (IN(5)) { PHASE_IDS();
        PrepA P{PR, args.in[I_MU_PREV], args.in[I_MU_NEXT], args.in[I_KK], Rb, Kb, Vb, KKb, HWb, XAb, SGb};
        prep_phase(lds + RING_OFF, P, gw, NGW, tid, lane);
        { float mx[8] = {0.f, 0.f, 0.f, 0.f, 0.f, 0.f, 0.f, 0.f};
          qk_norm_rows(QKV, mx, gw, NGW, lane);
          LAS unsigned* nl = (LAS unsigned*)(lds + RING_OFF + 65536);
          if (tid < 64) nl[tid] = 0u;
          __syncthreads();
          if ((lane & 7) == 0) {
#pragma unroll
              for (int j = 0; j < 8; ++j) (void)__hip_atomic_fetch_max(nl + (lane >> 3) + 8 * j, __float_as_uint(mx[j]), __ATOMIC_RELAXED, __HIP_MEMORY_SCOPE_WORKGROUP); }
          __syncthreads();
          if (tid < 64) (void)__hip_atomic_fetch_max((unsigned*)(ws + WS_CTL) + NORM_W + tid, nl[tid], __ATOMIC_RELAXED, __HIP_MEMORY_SCOPE_AGENT);
        }
    }
    SEAM(5);
    if (IN(6)) { PHASE_IDS(); __syncthreads();
#if !defined(P6_ONLY) || P6_ONLY == 0
        { pg8::Gemm g{HWb, W2T, T, 4096, LK}; pg8::StaticOrder S; S.init(T, 4096, G, bx); pg8::EpiLora<0> E{DECF, DECB, args.in[I_W0F], args.in[I_W0B]};
          pg8::gemm_phase<pg8::EpiLora<0>, pg8::StaticOrder, true, true>(lds + RING_OFF, g, S, E); }
#endif
#if !defined(P6_ONLY) || P6_ONLY == 1
        __syncthreads();
        { pg8::Gemm g{XAb, A2T, T, 4096, LK}; pg8::StaticOrder S; S.init(T, 4096, G, bx); pg8::EpiLora<1> E{AFb, ABb, args.in[I_A0F], args.in[I_A0B]};
          pg8::gemm_phase<pg8::EpiLora<1>, pg8::StaticOrder, true, true>(lds + RING_OFF, g, S, E); }
#endif
#if !defined(P6_ONLY) || P6_ONLY == 2
        __syncthreads();
        { pg8::Gemm g{SGb, G2T, T, 2048, LK}; pg8::StaticOrder S; S.init(T, 2048, G, bx); pg8::EpiLora<2> E{Gb, Gb, nullptr, nullptr};
          pg8::gemm_phase<pg8::EpiLora<2>, pg8::StaticOrder, true, true>(lds + RING_OFF, g, S, E); }
#endif
    }
    SEAM(6);
    if (IN(7)) { PHASE_IDS();
        if ((bx < 128 || G != 256) && args.pad != 2) {
            scan::Tensors P{Rb, Kb, KKb, Vb, {DECF, DECB}, {AFb, ABb}, args.in[I_KA], {YF, YB}, args.in[I_RK], {BONF, BONB}};
            const scan::ConvJob CJ{args.in[I_F2_WG], args.in[I_F2_WU], args.in[I_F2_WD], WGU2, WD2, G == 256 ? TAIL_GU + bx * 4 + (wave & 3) : scan::CV_ITEMS, 512};
            const int su0 = (G == 256) ? (bx & 7) * 16 + (bx >> 3) : bx;
            #if defined(PROBE_VARIANT) && PROBE_VARIANT != 0
            if (args.pad != 0) { for (int su = su0; su < 128; su += (G == 256 ? 128 : G)) scan::scan_unit<PROBE_VARIANT>(lds + RING_OFF, P, CJ, su >> 2, (su >> 1) & 1, su & 1, (float*)(ws + WS_X1)); } else
#endif
            for (int su = su0; su < 128; su += (G == 256 ? 128 : G)) scan::scan_unit<0>(lds + RING_OFF, P, CJ, su >> 2, (su >> 1) & 1, su & 1, nullptr);
        }
        const float lam = __uint_as_float(__builtin_amdgcn_readfirstlane(__float_as_uint(__expf(wave_sum(args.in[I_LQ1][lane] * args.in[I_LK1][lane])) - __expf(wave_sum(args.in[I_LQ2][lane] * args.in[I_LK2][lane])) + LAM_INIT)));
        const unsigned* nrm = (const unsigned*)(ws + WS_CTL) + NORM_W;
        for (;;) {
            __syncthreads();
            if (tid == 0) MISC[12] = __hip_atomic_fetch_add((unsigned*)(ws + WS_CTL) + QCTR_W + (args.pad == 2 ? 64 : 0), 1u, __ATOMIC_RELAXED, __HIP_MEMORY_SCOPE_AGENT);
            __syncthreads();
            const int u = __builtin_amdgcn_readfirstlane((int)MISC[12]);
            if (u >= 512) break;
            const int h = 15 - (u >> 5), qb = u & 31;
            const float sl2 = exp2f(-0.5f * (float)(h + 1)) * 1.4426950408889634f;
#define NRM_LD(i) __uint_as_float(__builtin_amdgcn_readfirstlane(__hip_atomic_load(nrm + (i), __ATOMIC_RELAXED, __HIP_MEMORY_SCOPE_AGENT)))
            const float qa = NRM_LD(2 * h), ka = NRM_LD(32 + 2 * h), qb2 = NRM_LD(2 * h + 1), kb2 = NRM_LD(32 + 2 * h + 1);
#undef NRM_LD
#if defined(PROBE_ATTVAR)
            if (args.pad == 2) att::attn_unit<PROBE_ATTVAR>(lds + RING_OFF, QKV, (float*)(ws + WS_X1 + 128 * MiB) + (size_t)bx * 32768, (bf16*)(ws + WS_X1), args.in[I_SUBLN], h, qb * 256, lam, sl2, qa, ka, qb2, kb2); else
#endif
            att::attn_unit<0>(lds + RING_OFF, QKV, O1 + (size_t)bx * 32768, XN, args.in[I_SUBLN], h, qb * 256, lam, sl2, qa, ka, qb2, kb2); }
    }
    SEAM(7);
    if (IN(8)) { PHASE_IDS();
        PostR P{YF, YB, Vb, BONF, BONB, Gb, args.in[I_GNW], args.in[I_GNB], XN};
        for (int t_ = gw; t_ < T; t_ += NGW) { int t = t_; asm volatile("" : "+s"(t)); post_r_row(P, t, lane); }
    }
    SEAM(8);
    if (IN(9)) { PHASE_IDS(); __syncthreads();
        if (G != 256) {
            conv_mat<1>(args.in[I_F2_WG], D, FF, WGU2, scr, gw, NGW, lane);
            conv_mat<2>(args.in[I_F2_WU], D, FF, WGU2, scr, gw, NGW, lane);
            conv_mat<0>(args.in[I_F2_WD], FF, D, WD2, scr, gw, NGW, lane);
            __syncthreads(); }
        pg8::Gemm g{XN, WOUT, T, D, D}; pg8::StaticOrder S; S.init(T, D, G, bx); pg8::EpiBf16Out E{Fb, D};
        pg8::gemm_phase<pg8::EpiBf16Out, pg8::StaticOrder, true, true>(lds + RING_OFF, g, S, E); }
    SEAM(9);
    if (IN(10)) { PHASE_IDS();
        rr_phase<false, false>(lds + RING_OFF, Fb, Hb, 1.0f, args.in[I_MIX_POST], args.in[I_F2_PRE], Hb, XN, nullptr, gw, NGW, tid, lane); }
    SEAM(10);
    if (IN(11)) { PHASE_IDS(); __syncthreads();
        pg8::Gemm g{XN, WGU2, T, 2 * FF, D}; pg8::StaticOrder S; S.init(T, 2 * FF, G, bx); pg8::EpiSwiGLU E{HID, FF};
        pg8::gemm_phase<pg8::EpiSwiGLU, pg8::StaticOrder, true, true>(lds + RING_OFF, g, S, E);
        if (G == 256 && bx >= 192) { __syncthreads(); conv_mat<0>(args.in[I_F2_WD], FF, D, WD2, scr, (bx - 192) * NWAVES + wave, 64 * NWAVES, lane, 0, TAIL_WD2); } }
    SEAM(11);
    if (IN(12)) { PHASE_IDS(); __syncthreads();
        pg8::Gemm g{HID, WD2, T, D, FF}; pg8::StaticOrder S; S.init(T, D, G, bx); pg8::EpiBf16Out E{Fb, D};
        pg8::gemm_phase<pg8::EpiBf16Out, pg8::StaticOrder, true, true>(lds + RING_OFF, g, S, E); }
    SEAM(12);
    if (IN(13)) { PHASE_IDS();
        rr_phase<true, false>(lds + RING_OFF, Fb, Hb, 0.5f, args.in[I_F2_POST], args.in[I_FINAL], nullptr, nullptr, args.out, gw, NGW, tid, lane); }
#undef IN
#undef SEAM
}

extern "C" void kernel_launch(void* const* d_in, const int* in_sizes, int n_in, void* d_out, int out_size, void* d_ws, size_t ws_size, hipStream_t stream) {
    static int grid = 0;
    if (grid == 0) {
        if (n_in != N_IN || in_sizes[0] != T * D || out_size != T * D || ws_size < WS_END) { fprintf(stderr, "kernel_launch: shape/workspace mismatch (n_in %d, in0 %d, out %d, ws %zu, need %zu)\n", n_in, n_in > 0 ? in_sizes[0] : -1, out_size, ws_size, (size_t)WS_END); grid = -1; return; }
        int dev = 0, cus = 0, per_cu = 0;
        if (hipGetDevice(&dev) != hipSuccess || hipDeviceGetAttribute(&cus, hipDeviceAttributeMultiprocessorCount, dev) != hipSuccess) { grid = -1; return; }
        if (hipFuncSetAttribute((const void*)hyb_fwd, hipFuncAttributeMaxDynamicSharedMemorySize, LDS_BYTES) != hipSuccess) { fprintf(stderr, "kernel_launch: hipFuncSetAttribute failed\n"); grid = -1; return; }
        if (hipOccupancyMaxActiveBlocksPerMultiprocessor(&per_cu, (const void*)hyb_fwd, NWAVES * 64, LDS_BYTES) != hipSuccess || per_cu < 1) { fprintf(stderr, "kernel_launch: occupancy query says %d blocks per CU\n", per_cu); (void)hipGetLastError(); grid = -1; return; }
        grid = cus;
    }
    if (grid < 0) return;
    if (hipMemsetAsync((char*)d_ws + WS_CTL, 0, CTL_ZERO_BYTES, stream) != hipSuccess) return;
    Args a{};
    for (int i = 0; i < N_IN; ++i) a.in[i] = (const float*)d_in[i];
    a.out = (float*)d_out; a.ws = (unsigned char*)d_ws;
#if defined(PROBE_REPEAT)
#ifndef PROBE_PAD
#define PROBE_PAD 1
#endif
#ifndef PROBE_DELAY
#define PROBE_DELAY 0
#endif
    a.ph_lo = 0; a.ph_hi = PROBE_REPEAT + 1 + PROBE_DELAY; hipLaunchKernelGGL(hyb_fwd, dim3(grid), dim3(NWAVES * 64), LDS_BYTES, stream, a);
    a.ph_lo = PROBE_REPEAT; a.ph_hi = PROBE_REPEAT + 1; a.li = 1; a.pad = PROBE_PAD; hipLaunchKernelGGL(hyb_fwd, dim3(grid), dim3(NWAVES * 64), LDS_BYTES, stream, a);
    if (PROBE_REPEAT + 1 + PROBE_DELAY < N_PHASES) { a.ph_lo = PROBE_REPEAT + 1 + PROBE_DELAY; a.ph_hi = N_PHASES; a.li = 2; a.pad = 0; hipLaunchKernelGGL(hyb_fwd, dim3(grid), dim3(NWAVES * 64), LDS_BYTES, stream, a); }
#elif MK_ONE_LAUNCH
    a.ph_lo = 0; a.ph_hi = N_PHASES;
    hipLaunchKernelGGL(hyb_fwd, dim3(grid), dim3(NWAVES * 64), LDS_BYTES, stream, a);
#else
    for (int p = 0; p < N_PHASES; ++p) { a.ph_lo = p; a.ph_hi = p + 1; hipLaunchKernelGGL(hyb_fwd, dim3(grid), dim3(NWAVES * 64), LDS_BYTES, stream, a); }
#endif
    const hipError_t le = hipPeekAtLastError();
    if (le != hipSuccess) fprintf(stderr, "kernel_launch: launch failed: %s\n", hipGetErrorName(le));
}
```
